# Optimizing an MI355X kernel written in HIP

```python
import jax
import jax.numpy as jnp
from jax import lax
import numpy as np

D_MODEL = 2048
BATCH = 4
SEQ = 2048
DEPTH = 4

HEAD_DIM = 128
ROPE_THETA = 10000.0
Q_BLOCK = 128
NEG_INF = -1e30
FOX_HEADS = 6
NSA_HEADS = 4
CMP_LEN = 32
CMP_STRIDE = 16
CMP_HIDDEN = 256
SLC_LEN = 64
SLC_TOPN = 16
WIN = 512
SLC_FORCE = 1e4
DSA_HEADS = 6
DSA_KV_RANK = 256
IDX_HEADS = 16
IDX_DIM = 64
IDX_TOPK_MAX = 256
D_FF = ((8 * D_MODEL + 3 * 256 - 1) // (3 * 256)) * 256
PLE_DIM = 256
ALPHA = (2 * DEPTH) ** 0.25
BETA = (8 * DEPTH) ** -0.25

SPLITS = (
    ('fox_q', FOX_HEADS * HEAD_DIM), ('fox_k', FOX_HEADS * HEAD_DIM), ('fox_v', FOX_HEADS * HEAD_DIM), ('fox_f', FOX_HEADS),
    ('nsa_q', NSA_HEADS * HEAD_DIM), ('nsa_kc', HEAD_DIM), ('nsa_vc', HEAD_DIM), ('nsa_ks', HEAD_DIM), ('nsa_vs', HEAD_DIM),
    ('nsa_kw', HEAD_DIM), ('nsa_vw', HEAD_DIM), ('nsa_g', 3 * NSA_HEADS),
    ('dsa_q', DSA_HEADS * HEAD_DIM), ('dsa_ckv', DSA_KV_RANK), ('idx_q', IDX_HEADS * IDX_DIM), ('idx_k', IDX_DIM), ('idx_w', IDX_HEADS),
    ('gate', 3 * D_MODEL),
)
IN_COLS = sum(w for _, w in SPLITS)

kernel_name = 'hybrid_fox_nsa_dsa_deepnorm'


def split_cols(z):
    offs = [int(o) for o in np.cumsum([w for _, w in SPLITS])[:-1]]
    parts = jnp.split(z, offs, axis=-1)
    return {name: part for (name, _), part in zip(SPLITS, parts)}


def heads(t, n):
    return t.reshape(t.shape[0], t.shape[1], n, -1)


def layer_norm(x, g, b, eps=1e-5):
    xf = x.astype(jnp.float32)
    mu = jnp.mean(xf, axis=-1, keepdims=True)
    var = jnp.mean(jnp.square(xf - mu), axis=-1, keepdims=True)
    return ((xf - mu) * lax.rsqrt(var + eps)).astype(x.dtype) * g + b


def rms_norm(x, g, eps=1e-6):
    xf = x.astype(jnp.float32)
    return (xf * lax.rsqrt(jnp.mean(jnp.square(xf), axis=-1, keepdims=True) + eps)).astype(x.dtype) * g


def rope_tables(n, dim):
    inv = 1.0 / (ROPE_THETA ** (jnp.arange(0, dim, 2, dtype=jnp.float32) / dim))
    ang = jnp.arange(n, dtype=jnp.float32)[:, None] * inv[None, :]
    return jnp.cos(ang), jnp.sin(ang)


def apply_rope(x, cos, sin):
    x1, x2 = jnp.split(x, 2, axis=-1)
    c = cos[:, None, :].astype(x.dtype)
    s = sin[:, None, :].astype(x.dtype)
    return jnp.concatenate([x1 * c - x2 * s, x1 * s + x2 * c], axis=-1)


def rope1(t, cos, sin):
    return apply_rope(t[:, :, None], cos, sin)[:, :, 0]


def to_blocks(a):
    B, S = a.shape[:2]
    return jnp.moveaxis(a.reshape((B, S // Q_BLOCK, Q_BLOCK) + a.shape[2:]), 1, 0)


def from_blocks(a):
    nb, B, Q = a.shape[:3]
    return jnp.moveaxis(a, 0, 1).reshape((B, nb * Q) + a.shape[3:])


def fox_attention(q, k, v, f_logit, f_bias):
    B, S, H, dh = q.shape
    pos = jnp.arange(S)
    scale = dh ** -0.5
    logf = jax.nn.log_sigmoid(f_logit.astype(jnp.float32) + f_bias.astype(jnp.float32))
    cum = jnp.cumsum(logf, axis=1)
    cum_k = jnp.transpose(cum, (0, 2, 1))

    def block(args):
        qb, cq, qpos = args
        s = jnp.einsum('bqhd,bkhd->bhqk', qb, k).astype(jnp.float32) * scale
        s = s + jnp.transpose(cq, (0, 2, 1))[..., None] - cum_k[:, :, None, :]
        s = jnp.where(pos[None, None, None, :] <= qpos[None, None, :, None], s, NEG_INF)
        pr = jax.nn.softmax(s, axis=-1).astype(v.dtype)
        return jnp.einsum('bhqk,bkhd->bqhd', pr, v)

    out = lax.map(block, (to_blocks(q), to_blocks(cum), pos.reshape(-1, Q_BLOCK)))
    return from_blocks(out)


def nsa_attention(q, kc_raw, vc_raw, ks, vs, kw, vw, g_logit, pe_k, pe_v, wk1, wk2, wv1, wv2, cos, sin):
    B, S, H, dh = q.shape
    pos = jnp.arange(S)
    scale = dh ** -0.5
    n_cmp = (S - CMP_LEN) // CMP_STRIDE + 1
    c_start = jnp.arange(n_cmp) * CMP_STRIDE
    c_end = c_start + CMP_LEN - 1
    tok = c_start[:, None] + jnp.arange(CMP_LEN)[None, :]

    def compress(raw, pe, w1, w2):
        blk = (raw[:, tok] + pe).reshape(B, n_cmp, CMP_LEN * dh)
        return jax.nn.gelu(blk @ w1) @ w2

    k_cmp = rope1(compress(kc_raw, pe_k, wk1, wk2), cos[c_end], sin[c_end])
    v_cmp = compress(vc_raw, pe_v, wv1, wv2)
    cmask = c_end[None, :] <= pos[:, None]
    s_c = jnp.einsum('bshd,bcd->bhsc', q, k_cmp).astype(jnp.float32) * scale
    p_c = jnp.where(cmask, jax.nn.softmax(jnp.where(cmask, s_c, NEG_INF), axis=-1), 0.0)
    o_cmp = jnp.einsum('bhsc,bcd->bshd', p_c.astype(v_cmp.dtype), v_cmp)
    n_slc = S // SLC_LEN
    s_start = jnp.arange(n_slc) * SLC_LEN
    overlap = jnp.maximum(jnp.minimum(c_end[:, None], s_start[None, :] + SLC_LEN - 1)
                          - jnp.maximum(c_start[:, None], s_start[None, :]) + 1, 0).astype(jnp.float32) / CMP_LEN
    imp = jnp.einsum('bhsc,cj->bsj', p_c, overlap)
    blk_id = jnp.arange(n_slc)[None, :]
    cur = (pos // SLC_LEN)[:, None]
    forced = (blk_id == 0) | (blk_id == cur) | (blk_id == cur - 1)
    imp = jnp.where(forced, SLC_FORCE, jnp.where(s_start[None, :] <= pos[:, None], imp, -SLC_FORCE))
    n_sel = min(SLC_TOPN, n_slc)
    _, sel = lax.top_k(imp, n_sel)
    ks_blk = ks.reshape(B, n_slc, SLC_LEN, dh)
    vs_blk = vs.reshape(B, n_slc, SLC_LEN, dh)
    kw_pad = jnp.pad(kw, ((0, 0), (WIN, 0), (0, 0)))
    vw_pad = jnp.pad(vw, ((0, 0), (WIN, 0), (0, 0)))
    band = WIN + Q_BLOCK
    gather = jax.vmap(lambda kb, ib: kb[ib])

    def block(args):
        qb, selb, qpos, start = args
        gk = gather(ks_blk, selb).reshape(B, Q_BLOCK, n_sel * SLC_LEN, dh)
        gv = gather(vs_blk, selb).reshape(B, Q_BLOCK, n_sel * SLC_LEN, dh)
        kpos = (selb[..., None] * SLC_LEN + jnp.arange(SLC_LEN)).reshape(B, Q_BLOCK, n_sel * SLC_LEN)
        s = jnp.einsum('bqhd,bqkd->bhqk', qb, gk).astype(jnp.float32) * scale
        s = jnp.where((kpos <= qpos[None, :, None])[:, None], s, NEG_INF)
        o_s = jnp.einsum('bhqk,bqkd->bqhd', jax.nn.softmax(s, axis=-1).astype(gv.dtype), gv)
        kwb = lax.dynamic_slice_in_dim(kw_pad, start, band, axis=1)
        vwb = lax.dynamic_slice_in_dim(vw_pad, start, band, axis=1)
        wpos = start - WIN + jnp.arange(band)
        dist = qpos[:, None] - wpos[None, :]
        wmask = (dist >= 0) & (dist < WIN) & (wpos[None, :] >= 0)
        s_w = jnp.einsum('bqhd,bkd->bhqk', qb, kwb).astype(jnp.float32) * scale
        s_w = jnp.where(wmask[None, None], s_w, NEG_INF)
        o_w = jnp.einsum('bhqk,bkd->bqhd', jax.nn.softmax(s_w, axis=-1).astype(vwb.dtype), vwb)
        return o_s, o_w

    nb = S // Q_BLOCK
    o_slc, o_win = lax.map(block, (to_blocks(q), to_blocks(sel), pos.reshape(nb, Q_BLOCK), jnp.arange(nb) * Q_BLOCK))
    g = jax.nn.sigmoid(g_logit).reshape(B, S, H, 3)
    return g[..., 0:1] * o_cmp + g[..., 1:2] * from_blocks(o_slc) + g[..., 2:3] * from_blocks(o_win)


def dsa_attention(q, k, v, iq, ik, iw):
    B, S, H, dh = q.shape
    pos = jnp.arange(S)
    scale = dh ** -0.5
    k_top = min(IDX_TOPK_MAX, S // 4)
    iw = iw.astype(jnp.float32) * (IDX_HEADS ** -0.5 * IDX_DIM ** -0.5)
    gather = jax.vmap(lambda kb, ib: kb[ib])

    def block(args):
        qb, iqb, iwb, qpos = args
        sc = jax.nn.relu(jnp.einsum('bqhd,bkd->bqhk', iqb, ik).astype(jnp.float32))
        sc = jnp.einsum('bqhk,bqh->bqk', sc, iwb)
        sc = jnp.where(pos[None, None, :] <= qpos[None, :, None], sc, NEG_INF)
        _, idx = lax.top_k(sc, k_top)
        gk = gather(k, idx)
        gv = gather(v, idx)
        s = jnp.einsum('bqhd,bqkd->bhqk', qb, gk).astype(jnp.float32) * scale
        s = jnp.where((idx <= qpos[None, :, None])[:, None], s, NEG_INF)
        return jnp.einsum('bhqk,bqkd->bqhd', jax.nn.softmax(s, axis=-1).astype(gv.dtype), gv)

    out = lax.map(block, (to_blocks(q), to_blocks(iq), to_blocks(iw), pos.reshape(-1, Q_BLOCK)))
    return from_blocks(out)


def setup_inputs(seed: int = 0) -> dict:
    key = jax.random.key(seed)
    ks = jax.random.split(key, 24)
    L, D = DEPTH, D_MODEL
    cw = CMP_LEN * HEAD_DIM

    def nrm(k, shape, s):
        return jax.random.normal(k, shape, jnp.float32) * s

    return {
        'x': nrm(ks[0], (BATCH, SEQ, D), 1.0),
        'p': nrm(ks[1], (DEPTH, BATCH, SEQ, PLE_DIM), 1.0),
        'w_in': nrm(ks[2], (L, D, IN_COLS), D ** -0.5),
        'fox_f_bias': 3.0 + nrm(ks[3], (L, FOX_HEADS), 0.5),
        'nsa_pe_k': nrm(ks[4], (L, CMP_LEN, HEAD_DIM), 0.1),
        'nsa_pe_v': nrm(ks[5], (L, CMP_LEN, HEAD_DIM), 0.1),
        'nsa_cmp_k1': nrm(ks[6], (L, cw, CMP_HIDDEN), cw ** -0.5),
        'nsa_cmp_k2': nrm(ks[7], (L, CMP_HIDDEN, HEAD_DIM), CMP_HIDDEN ** -0.5),
        'nsa_cmp_v1': nrm(ks[8], (L, cw, CMP_HIDDEN), cw ** -0.5),
        'nsa_cmp_v2': nrm(ks[9], (L, CMP_HIDDEN, HEAD_DIM), CMP_HIDDEN ** -0.5),
        'dsa_kv_norm': 1.0 + nrm(ks[10], (L, DSA_KV_RANK), 0.02),
        'dsa_kv_up': nrm(ks[11], (L, DSA_KV_RANK, 2 * HEAD_DIM), DSA_KV_RANK ** -0.5),
        'w_br_fox': nrm(ks[12], (L, FOX_HEADS * HEAD_DIM, D), (FOX_HEADS * HEAD_DIM) ** -0.5),
        'w_br_nsa': nrm(ks[13], (L, NSA_HEADS * HEAD_DIM, D), (NSA_HEADS * HEAD_DIM) ** -0.5),
        'w_br_dsa': nrm(ks[14], (L, DSA_HEADS * HEAD_DIM, D), (DSA_HEADS * HEAD_DIM) ** -0.5),
        'w_out': nrm(ks[15], (L, D, D), BETA * D ** -0.5),
        'ln1_g': 1.0 + nrm(ks[16], (L, D), 0.02),
        'ln1_b': nrm(ks[17], (L, D), 0.02),
        'w_ffn_in': nrm(ks[18], (L, D, 2 * D_FF), BETA * D ** -0.5),
        'w_ffn_out': nrm(ks[19], (L, D_FF, D), BETA * D_FF ** -0.5),
        'ln2_g': 1.0 + nrm(ks[20], (L, D), 0.02),
        'ln2_b': nrm(ks[21], (L, D), 0.02),
        'w_ple_in': nrm(ks[22], (L, PLE_DIM, D), BETA * PLE_DIM ** -0.5),
        'w_ple_gate': nrm(ks[23], (L, D, D), D ** -0.5),
    }


def reference(x, p, w_in, fox_f_bias, nsa_pe_k, nsa_pe_v, nsa_cmp_k1, nsa_cmp_k2, nsa_cmp_v1, nsa_cmp_v2,
              dsa_kv_norm, dsa_kv_up, w_br_fox, w_br_nsa, w_br_dsa, w_out, ln1_g, ln1_b,
              w_ffn_in, w_ffn_out, ln2_g, ln2_b, w_ple_in, w_ple_gate):
    B, S, _ = x.shape
    cos, sin = rope_tables(S, HEAD_DIM)
    cos_i, sin_i = rope_tables(S, IDX_DIM)
    h = x
    for i in range(DEPTH):
        z = split_cols(h @ w_in[i])
        o_fox = fox_attention(heads(z['fox_q'], FOX_HEADS), heads(z['fox_k'], FOX_HEADS),
                              heads(z['fox_v'], FOX_HEADS), z['fox_f'], fox_f_bias[i])
        o_nsa = nsa_attention(apply_rope(heads(z['nsa_q'], NSA_HEADS), cos, sin),
                              z['nsa_kc'], z['nsa_vc'], rope1(z['nsa_ks'], cos, sin), z['nsa_vs'],
                              rope1(z['nsa_kw'], cos, sin), z['nsa_vw'], z['nsa_g'],
                              nsa_pe_k[i], nsa_pe_v[i], nsa_cmp_k1[i], nsa_cmp_k2[i], nsa_cmp_v1[i], nsa_cmp_v2[i],
                              cos, sin)
        k_d, v_d = jnp.split(rms_norm(z['dsa_ckv'], dsa_kv_norm[i]) @ dsa_kv_up[i], 2, axis=-1)
        o_dsa = dsa_attention(apply_rope(heads(z['dsa_q'], DSA_HEADS), cos, sin),
                              rope1(k_d, cos, sin), v_d,
                              apply_rope(heads(z['idx_q'], IDX_HEADS), cos_i, sin_i),
                              rope1(z['idx_k'], cos_i, sin_i), z['idx_w'])
        g_fox, g_nsa, g_dsa = jnp.split(jax.nn.sigmoid(z['gate']), 3, axis=-1)
        mixed = (g_fox * (o_fox.reshape(B, S, -1) @ w_br_fox[i])
                 + g_nsa * (o_nsa.reshape(B, S, -1) @ w_br_nsa[i])
                 + g_dsa * (o_dsa.reshape(B, S, -1) @ w_br_dsa[i]))
        h = layer_norm(ALPHA * h + mixed @ w_out[i], ln1_g[i], ln1_b[i])
        a, b = jnp.split(h @ w_ffn_in[i], 2, axis=-1)
        h = layer_norm(ALPHA * h + (jax.nn.silu(a) * b) @ w_ffn_out[i], ln2_g[i], ln2_b[i])
        h = h + (p[i] @ w_ple_in[i]) * jax.nn.sigmoid(h @ w_ple_gate[i])
    return h
```

```cpp
#include <hip/hip_runtime.h>
#include <hip/hip_bf16.h>
#include <cstdio>
#include <cstdint>

#define TOUCH 0
namespace pg8 {
#define PG8_LAS __attribute__((address_space(3)))
typedef unsigned short bf16_t;
typedef short bf16x8 __attribute__((ext_vector_type(8)));
typedef float f32x4 __attribute__((ext_vector_type(4)));
typedef unsigned u32x4 __attribute__((ext_vector_type(4)));
constexpr int BM = 256, BK = 64, HALF = 128, HTB = HALF * BK * 2  , STAGE_BYTES = 8 * HTB, NXCD = 8, WGM = 8;

__host__ __device__ __forceinline__ int lds_byte(int r, int c) { const int st = (r >> 4) * 2 + (c >> 5), rr = r & 15, cc = c & 31, ob = rr * 64 + cc * 2; return st * 1024 + (ob ^ (((ob >> 9) & 1) << 5)); }
__host__ __device__ __forceinline__ void stage_rc(int b, int& R, int& C) { const int st = b / 1024, sb = b % 1024, swz = sb ^ (((sb >> 9) & 1) << 5); R = (st >> 1) * 16 + swz / 64; C = (st & 1) * 32 + (swz % 64) / 2; }
__host__ __device__ __forceinline__ int perm32(int rho) { const int n = rho >> 4, i = rho & 15; return 8 * (i >> 2) + 4 * n + (i & 3); }

struct Unit { int pm, pn; int seg = 0; };
typedef int v4i_t __attribute__((ext_vector_type(4)));
typedef int v8i_t __attribute__((ext_vector_type(8)));
struct Gemm { const bf16_t* A; const bf16_t* Bt; int M, N, K; int sA = 0x7f7f7f7f, sB = 0x7f7f7f7f; };
struct SegGemm { const bf16_t* A[4]; const bf16_t* Bt[4]; int nt[4]; int ld; int sA = 0x7f7f7f7f, sB = 0x7f7f7f7f; };
__device__ __forceinline__ int gm_ld(const Gemm& g) { return g.K; }
__device__ __forceinline__ int gm_ld(const SegGemm& g) { return g.ld; }
__device__ __forceinline__ int gm_nt(const Gemm& g, int) { return g.K / 64; }
__device__ __forceinline__ int gm_nt(const SegGemm& g, int s) { return s == 0 ? g.nt[0] : s == 1 ? g.nt[1] : s == 2 ? g.nt[2] : g.nt[3]; }
__device__ __forceinline__ const char* gm_a(const Gemm& g, int) { return (const char*)g.A; }
__device__ __forceinline__ const char* gm_a(const SegGemm& g, int s) { return (const char*)(s == 0 ? g.A[0] : s == 1 ? g.A[1] : s == 2 ? g.A[2] : g.A[3]); }
__device__ __forceinline__ const char* gm_b(const Gemm& g, int) { return (const char*)g.Bt; }
__device__ __forceinline__ const char* gm_b(const SegGemm& g, int s) { return (const char*)(s == 0 ? g.Bt[0] : s == 1 ? g.Bt[1] : s == 2 ? g.Bt[2] : g.Bt[3]); }

struct StaticOrder {
    int nM, nN, nwg, G, c;
    __host__ __device__ void init(int M, int N, int G_, int c_) { nM = M / BM; nN = N / BM; nwg = nM * nN; G = G_; c = c_; }
    __host__ __device__ bool next(int i, Unit& u) const {
        const long L = (long)i * G + c; if (L >= nwg) return false;
        int wgid = (int)L; { const int q = nwg / NXCD, r = nwg % NXCD, xcd = wgid % NXCD, off = wgid / NXCD; wgid = (xcd < r ? xcd * (q + 1) : r * (q + 1) + (xcd - r) * q) + off; }
        const int nig = WGM * nN, gid = wgid / nig, fm = gid * WGM, gsz = (nM - fm) < WGM ? (nM - fm) : WGM;
        u.pm = fm + ((wgid % nig) % gsz); u.pn = (wgid % nig) / gsz; return true;
    }
    __device__ __forceinline__ void a_ready(const Unit&) const {}
    __device__ __forceinline__ void done(const Unit&) const {}
};

typedef float f32x2cv __attribute__((ext_vector_type(2))); typedef __bf16 bf16x2cv __attribute__((ext_vector_type(2)));
__device__ __forceinline__ unsigned cvt_pk_bf16(float lo, float hi) { f32x2cv v = {lo, hi}; bf16x2cv b = __builtin_convertvector(v, bf16x2cv); return __builtin_bit_cast(unsigned, b); }
typedef float f32x2 __attribute__((ext_vector_type(2)));
typedef float f32x2e __attribute__((ext_vector_type(2)));
#define PG8_GAS __attribute__((address_space(1)))
__device__ __forceinline__ float fast_sigmoid(float x) { return __builtin_amdgcn_rcpf(1.0f + __builtin_amdgcn_exp2f(-1.4426950408889634f * x)); }
__device__ __forceinline__ u32x4 pack8(const f32x4 a, const f32x4 b) { u32x4 w; w.x = cvt_pk_bf16(a[0], a[1]); w.y = cvt_pk_bf16(a[2], a[3]); w.z = cvt_pk_bf16(b[0], b[1]); w.w = cvt_pk_bf16(b[2], b[3]); return w; }
__device__ __forceinline__ float bf_lo(unsigned w) { return __uint_as_float(w << 16); }
__device__ __forceinline__ float bf_hi(unsigned w) { return __uint_as_float(w & 0xffff0000u); }

#define QSCALE 0.12751743074602467f

struct EpiInProj {
    static constexpr bool PERM = true, AFTER_DRAIN = false;
    PG8_GAS bf16_t *FQ, *FK, *FV, *NQ, *KC, *VC, *KS, *VS, *KW, *VW, *DQ, *CKV, *IQ, *IK; PG8_GAS unsigned char* G8; PG8_GAS float* SM; const PG8_GAS f32x2e* rope128; const PG8_GAS f32x2e* rope64;
    int mode;
    __device__ __forceinline__ void operator()(const f32x4 (&acc)[2][2][4][2], const Unit& u, int wr, int wc, int fr, int fq) const {
        const int i_ = u.pn;
        const int pn = mode == 0 ? (i_ < 6 ? i_ : i_ < 8 ? i_ + 3 : i_ < 11 ? i_ + 6 : i_ + 7) : (i_ < 24 ? 23 + i_ : i_ < 27 ? i_ - 18 : i_ < 30 ? i_ - 16 : 17);
#pragma unroll
        for (int bj = 0; bj < 2; ++bj) {
            const int cw = 32 * wc + 8 * fq;
            int kind; PG8_GAS bf16_t* dst; int pitch, col;
            if (pn < 3)        { kind = 0x100; dst = FQ; pitch = 768; col = pn * 256 + 128 * bj + cw; }
            else if (pn < 6)   { kind = 0; dst = FK; pitch = 768; col = (pn - 3) * 256 + 128 * bj + cw; }
            else if (pn < 9)   { kind = 0; dst = FV; pitch = 768; col = (pn - 6) * 256 + 128 * bj + cw; }
            else if (pn < 11)  { kind = 0x101; dst = NQ; pitch = 512; col = (pn - 9) * 256 + 128 * bj + cw; }
            else if (pn == 11) { kind = 0; dst = bj ? VC : KC; pitch = 128; col = cw; }
            else if (pn == 12) { kind = bj ? 0 : 1; dst = bj ? VS : KS; pitch = 128; col = cw; }
            else if (pn == 13) { kind = bj ? 0 : 1; dst = bj ? VW : KW; pitch = 128; col = cw; }
            else if (pn < 17)  { kind = 0x101; dst = DQ; pitch = 768; col = (pn - 14) * 256 + 128 * bj + cw; }
            else if (pn == 17) { kind = 0; dst = CKV; pitch = 256; col = 128 * bj + cw; }
            else if (pn < 22)  { kind = 2; dst = IQ; pitch = 1024; col = (pn - 18) * 256 + 128 * bj + cw; }
            else if (pn == 22) { if (bj == 0) { if (cw < 64) { kind = 2; dst = IK; pitch = 64; col = cw; } else { kind = 4; dst = nullptr; pitch = 64; col = cw - 64; } } else { kind = 5; dst = nullptr; pitch = 0; col = 0; } }
            else               { kind = 3; dst = nullptr; pitch = 6144; col = (pn - 23) * 256 + 128 * bj + cw; }
            if (kind == 5) continue;
            const float sc = (kind & 0x100) ? QSCALE : 1.0f; const int k = kind & 0xff;
#pragma unroll
            for (int ai = 0; ai < 2; ++ai)
#pragma unroll
                for (int m = 0; m < 4; ++m) {
                    const int row = u.pm * BM + ai * HALF + wr * 64 + m * 16 + fr; const int pos = row & 2047;
                    f32x4 v0 = acc[ai][bj][m][0], v1 = acc[ai][bj][m][1];
                    if (k == 1 || k == 2) {
                        const PG8_GAS f32x2e* tb = (k == 1) ? rope128 + (size_t)pos * 64 + (cw >> 1) : rope64 + (size_t)pos * 32 + ((cw & 63) >> 1);
                        const f32x4 cs0 = *(const PG8_GAS f32x4*)tb, cs1 = *(const PG8_GAS f32x4*)(tb + 2);
                        f32x4 o0, o1;
                        o0[0] = v0[0] * cs0[0] - v0[1] * cs0[1]; o0[1] = v0[0] * cs0[1] + v0[1] * cs0[0];
                        o0[2] = v0[2] * cs0[2] - v0[3] * cs0[3]; o0[3] = v0[2] * cs0[3] + v0[3] * cs0[2];
                        o1[0] = v1[0] * cs1[0] - v1[1] * cs1[1]; o1[1] = v1[0] * cs1[1] + v1[1] * cs1[0];
                        o1[2] = v1[2] * cs1[2] - v1[3] * cs1[3]; o1[3] = v1[2] * cs1[3] + v1[3] * cs1[2];
                        v0 = o0; v1 = o1;
                    } else if (k == 3) {
                        typedef unsigned u32x2g __attribute__((ext_vector_type(2))); u32x2g w; unsigned x = 0u;
#pragma unroll
                        for (int e = 0; e < 4; ++e) x = __builtin_amdgcn_cvt_pk_u8_f32(255.0f * fast_sigmoid(v0[e]), e, x);
                        w.x = x; x = 0u;
#pragma unroll
                        for (int e = 0; e < 4; ++e) x = __builtin_amdgcn_cvt_pk_u8_f32(255.0f * fast_sigmoid(v1[e]), e, x);
                        w.y = x; *(PG8_GAS u32x2g*)(G8 + (size_t)row * 6144 + col) = w; continue;
                    }
                    if (k == 4) { PG8_GAS float* p = SM + (size_t)row * 64 + col; *(PG8_GAS f32x4*)p = v0; *(PG8_GAS f32x4*)(p + 4) = v1; }
                    else { v0 = v0 * sc; v1 = v1 * sc; *(PG8_GAS u32x4*)(dst + (size_t)row * pitch + col) = pack8(v0, v1); }
                }
        }
    }
};

struct EpiGate {
    static constexpr bool PERM = true, AFTER_DRAIN = false;
    PG8_GAS unsigned char* G;
    __device__ __forceinline__ void operator()(const f32x4 (&acc)[2][2][4][2], const Unit& u, int wr, int wc, int fr, int fq) const {
        typedef unsigned u32x2e __attribute__((ext_vector_type(2)));
#pragma unroll
        for (int ai = 0; ai < 2; ++ai)
#pragma unroll
            for (int m = 0; m < 4; ++m) {
                const int row = u.pm * BM + ai * HALF + wr * 64 + m * 16 + fr;
#pragma unroll
                for (int bj = 0; bj < 2; ++bj) { const f32x4 v0 = acc[ai][bj][m][0], v1 = acc[ai][bj][m][1]; u32x2e w; unsigned x = 0u;
#pragma unroll
                    for (int e = 0; e < 4; ++e) x = __builtin_amdgcn_cvt_pk_u8_f32(255.0f * fast_sigmoid(v0[e]), e, x);
                    w.x = x; x = 0u;
#pragma unroll
                    for (int e = 0; e < 4; ++e) x = __builtin_amdgcn_cvt_pk_u8_f32(255.0f * fast_sigmoid(v1[e]), e, x);
                    w.y = x;
                    *(PG8_GAS u32x2e*)(G + (size_t)row * 6144 + u.pn * BM + bj * HALF + wc * 32 + 8 * fq) = w; }
            }
    }
};

struct EpiBranchSeg {
    static constexpr bool PERM = true, AFTER_DRAIN = false, KEEP_ACC = true;
    static __device__ __forceinline__ bool keeps(const Unit& u) { return u.seg < 2; }
    const PG8_GAS unsigned char* G; PG8_GAS bf16_t* MIXB; PG8_GAS bf16_t* PLB;
    __device__ __forceinline__ void operator()(f32x4 (&acc)[2][2][4][2], const Unit& u, int wr, int wc, int fr, int fq) const {
        typedef unsigned u32x2e __attribute__((ext_vector_type(2)));
        const int seg = u.seg;
        const int col0 = u.pn * BM + wc * 32 + 8 * fq;
#pragma unroll
        for (int ai = 0; ai < 2; ++ai) {
            const int row0 = u.pm * BM + ai * HALF + wr * 64 + fr;
            if (seg == 3) {
#pragma unroll
                for (int m = 0; m < 4; ++m)
#pragma unroll
                    for (int bj = 0; bj < 2; ++bj) *(PG8_GAS u32x4*)(PLB + (size_t)(row0 + m * 16) * 2048 + col0 + bj * HALF) = pack8(acc[ai][bj][m][0], acc[ai][bj][m][1]);
            } else {
                u32x2e gn[4][2], gd[4][2];
#pragma unroll
                for (int m = 0; m < 4; ++m)
#pragma unroll
                    for (int bj = 0; bj < 2; ++bj) { const PG8_GAS unsigned char* gp = G + (size_t)(row0 + m * 16) * 6144 + seg * 2048 + col0 + bj * HALF;
                        gn[m][bj] = *(const PG8_GAS u32x2e*)gp; gd[m][bj] = seg < 2 ? *(const PG8_GAS u32x2e*)(gp + 2048) : (u32x2e){0x01010101u, 0x01010101u}; }
                asm volatile("" ::: "memory");
#pragma unroll
                for (int m = 0; m < 4; ++m)
#pragma unroll
                    for (int bj = 0; bj < 2; ++bj) {
                        f32x4 f[2];
#pragma unroll
                        for (int hh = 0; hh < 2; ++hh) { const unsigned a_ = hh ? gn[m][bj].y : gn[m][bj].x, d_ = hh ? gd[m][bj].y : gd[m][bj].x;
#pragma unroll
                            for (int e2 = 0; e2 < 4; ++e2) { float nu = (float)((a_ >> (8 * e2)) & 0xffu); if (seg > 0) nu = fmaxf(nu, 1.0f);
                                const float de = seg < 2 ? __builtin_amdgcn_rcpf(fmaxf((float)((d_ >> (8 * e2)) & 0xffu), 1.0f)) : (1.0f / 255.0f);
                                f[hh][e2] = nu * de; } }
                        acc[ai][bj][m][0] = acc[ai][bj][m][0] * f[0]; acc[ai][bj][m][1] = acc[ai][bj][m][1] * f[1];
                        if (seg == 2) *(PG8_GAS u32x4*)(MIXB + (size_t)(row0 + m * 16) * 2048 + col0 + bj * HALF) = pack8(acc[ai][bj][m][0], acc[ai][bj][m][1]);
                    }
            }
            asm volatile("" ::: "memory");
        }
    }
};
struct PanelOrder {
    int nM, nN, G, c;
    __device__ __forceinline__ void init(int M, int N, int G_, int c_) { nM = M / BM; nN = N / BM; G = G_; c = c_; }
    __device__ __forceinline__ bool next(int i, Unit& u) const { const int per = G / nM; if (per < 1 || c >= per * nM) return false; const int pn = c / nM + per * i; if (pn >= nN) return false; u.pm = c % nM; u.pn = pn; u.seg = i; return true; }
    __device__ __forceinline__ void a_ready(const Unit&) const {}
    __device__ __forceinline__ void done(const Unit&) const {}
};
struct SegOrder4 {
    StaticOrder base;
    __device__ __forceinline__ bool next(int i, Unit& u) const { const bool ok = base.next(i >> 2, u); u.seg = i & 3; return ok; }
    __device__ __forceinline__ void a_ready(const Unit&) const {}
    __device__ __forceinline__ void done(const Unit&) const {}
};

typedef _Float16 f16x8e __attribute__((ext_vector_type(8)));
typedef float f32x8e __attribute__((ext_vector_type(8)));
__device__ __forceinline__ void ld_h8(const PG8_GAS _Float16* p, f32x4& a, f32x4& b) { const f16x8e h = *(const PG8_GAS f16x8e*)p; const f32x8e f = __builtin_convertvector(h, f32x8e);
    a = (f32x4){f[0], f[1], f[2], f[3]}; b = (f32x4){f[4], f[5], f[6], f[7]}; }
__device__ __forceinline__ void st_h8(PG8_GAS _Float16* p, const f32x4& a, const f32x4& b) { const f32x8e f = {a[0], a[1], a[2], a[3], b[0], b[1], b[2], b[3]}; *(PG8_GAS f16x8e*)p = __builtin_convertvector(f, f16x8e); }
__device__ __forceinline__ void row_stats_table(const PG8_GAS f32x2e* ST, int pm, PG8_LAS f32x2e* tbl, int tid) {
    if (tid < 256) {
        const PG8_GAS f32x4* p = (const PG8_GAS f32x4*)(ST + (size_t)(pm * BM + tid) * 8);
        float s = 0.f, q = 0.f;
#pragma unroll
        for (int i = 0; i < 4; ++i) { const f32x4 w = p[i]; s += w[0]; q += w[1]; s += w[2]; q += w[3]; }
        const float mean = s * (1.0f / 2048.0f), var = q * (1.0f / 2048.0f) - mean * mean;
        tbl[tid] = (f32x2e){mean, 1.0f / __builtin_sqrtf(var + 1e-5f)};
    }
    asm volatile("s_waitcnt lgkmcnt(0)\n\ts_barrier" ::: "memory");
}
template <bool LNRES, bool OUT8> struct EpiResidStats {
    static constexpr bool PERM = true, AFTER_DRAIN = false;
    const PG8_GAS _Float16* res; PG8_GAS _Float16* out; float alpha;
    const PG8_GAS f32x2e* STin; const PG8_GAS float* gr; const PG8_GAS float* br;
    const PG8_GAS float* gn; PG8_GAS unsigned char* xo; PG8_GAS f32x2e* STout;
    PG8_LAS unsigned char* lds; int tid;
    static constexpr int RB = LNRES ? 1 : 2;
    __device__ __forceinline__ void operator()(const f32x4 (&acc)[2][2][4][2], const Unit& u, int wr, int wc, int fr, int fq) const {
        typedef unsigned u32x2e __attribute__((ext_vector_type(2)));
        PG8_LAS f32x2e* tbl = (PG8_LAS f32x2e*)(lds + 133120);
        if (LNRES) row_stats_table(STin, u.pm, tbl, tid);
        const int col0 = u.pn * BM + wc * 32 + 8 * fq;
        PG8_LAS f32x2e* part = (PG8_LAS f32x2e*)(lds + 133120 + 2048);
        f32x4 gnv[2][2], grv[2][2], brv[2][2];
#pragma unroll
        for (int bj = 0; bj < 2; ++bj)
#pragma unroll
            for (int n = 0; n < 2; ++n) { const int c = col0 + bj * HALF + 4 * n; gnv[bj][n] = *(const PG8_GAS f32x4*)(gn + c);
                if (LNRES) { grv[bj][n] = *(const PG8_GAS f32x4*)(gr + c); brv[bj][n] = *(const PG8_GAS f32x4*)(br + c); } }
#pragma unroll
        for (int ai = 0; ai < 2; ++ai)
#pragma unroll
            for (int mp = 0; mp < 4 / RB; ++mp) {
                const int rl0 = ai * HALF + wr * 64 + mp * (16 * RB) + fr;
                f32x4 r[RB][2][2];
#pragma unroll
                for (int mm = 0; mm < RB; ++mm)
#pragma unroll
                    for (int bj = 0; bj < 2; ++bj) { const size_t off = (size_t)(u.pm * BM + rl0 + mm * 16) * 2048 + col0 + bj * HALF; ld_h8(res + off, r[mm][bj][0], r[mm][bj][1]); }
                asm volatile("" ::: "memory");
#pragma unroll
                for (int mm = 0; mm < RB; ++mm) { const int m = RB * mp + mm; float s = 0.f, q = 0.f;
                    f32x2e st; if (LNRES) st = tbl[rl0 + mm * 16];
#pragma unroll
                    for (int bj = 0; bj < 2; ++bj) { const size_t off = (size_t)(u.pm * BM + rl0 + mm * 16) * 2048 + col0 + bj * HALF;
                        f32x4 r0 = r[mm][bj][0], r1 = r[mm][bj][1];
                        if (LNRES) { r0 = (r0 - st.x) * st.y * grv[bj][0] + brv[bj][0]; r1 = (r1 - st.x) * st.y * grv[bj][1] + brv[bj][1]; }
                        const f32x4 v0 = r0 * alpha + acc[ai][bj][m][0], v1 = r1 * alpha + acc[ai][bj][m][1];
                        st_h8(out + off, v0, v1);
                        s += ((v0[0] + v0[1]) + (v0[2] + v0[3])) + ((v1[0] + v1[1]) + (v1[2] + v1[3]));
                        q += ((v0[0] * v0[0] + v0[1] * v0[1]) + (v0[2] * v0[2] + v0[3] * v0[3])) + ((v1[0] * v1[0] + v1[1] * v1[1]) + (v1[2] * v1[2] + v1[3] * v1[3]));
                        const f32x4 a0 = v0 * gnv[bj][0], a1 = v1 * gnv[bj][1];
                        if (OUT8) { u32x2e w8; unsigned x = 0u; x = __builtin_amdgcn_cvt_pk_fp8_f32(a0[0], a0[1], x, false); x = __builtin_amdgcn_cvt_pk_fp8_f32(a0[2], a0[3], x, true); w8.x = x;
                            x = 0u; x = __builtin_amdgcn_cvt_pk_fp8_f32(a1[0], a1[1], x, false); x = __builtin_amdgcn_cvt_pk_fp8_f32(a1[2], a1[3], x, true); w8.y = x; *(PG8_GAS u32x2e*)(xo + off) = w8; }
                        else *(PG8_GAS u32x4*)((PG8_GAS bf16_t*)xo + off) = pack8(a0, a1); }
                    s += __shfl_xor(s, 16); q += __shfl_xor(q, 16); s += __shfl_xor(s, 32); q += __shfl_xor(q, 32);
                    if (fq == 0) part[(rl0 + mm * 16) * 4 + wc] = (f32x2e){s, q};
                }
                asm volatile("" ::: "memory");
            }
        asm volatile("s_waitcnt lgkmcnt(0)\n\ts_barrier" ::: "memory");
        if (tid < 256) { const f32x2e p0 = part[tid * 4], p1 = part[tid * 4 + 1], p2 = part[tid * 4 + 2], p3 = part[tid * 4 + 3];
            STout[(size_t)(u.pm * BM + tid) * 8 + u.pn] = (f32x2e){(p0.x + p1.x) + (p2.x + p3.x), (p0.y + p1.y) + (p2.y + p3.y)}; }
    }
};

struct EpiSwiGLU {
    static constexpr bool PERM = true, AFTER_DRAIN = false;
    PG8_GAS unsigned char* HID;
    const PG8_GAS f32x2e* ST; const PG8_GAS float* c1; const PG8_GAS float* c2; PG8_LAS unsigned char* lds; int tid;
    __device__ __forceinline__ void operator()(const f32x4 (&acc)[2][2][4][2], const Unit& u, int wr, int wc, int fr, int fq) const {
        typedef unsigned u32x2e __attribute__((ext_vector_type(2)));
        PG8_LAS f32x2e* tbl = (PG8_LAS f32x2e*)(lds + 133120);
        if (u.seg == 0) row_stats_table(ST, u.pm, tbl, tid);
        const int cp = u.pn * BM + wc * 32 + 8 * fq;
        f32x4 ca1[2], ca2[2], cb1[2], cb2[2];
#pragma unroll
        for (int n = 0; n < 2; ++n) { ca1[n] = *(const PG8_GAS f32x4*)(c1 + cp + 4 * n); ca2[n] = *(const PG8_GAS f32x4*)(c2 + cp + 4 * n); cb1[n] = *(const PG8_GAS f32x4*)(c1 + cp + HALF + 4 * n); cb2[n] = *(const PG8_GAS f32x4*)(c2 + cp + HALF + 4 * n); }
#pragma unroll
        for (int ai = 0; ai < 2; ++ai)
#pragma unroll
            for (int m = 0; m < 4; ++m) {
                const int rl = ai * HALF + wr * 64 + m * 16 + fr; const f32x2e st = tbl[rl]; const float nm = -st.x;
                u32x2e w;
#pragma unroll
                for (int n = 0; n < 2; ++n) { const f32x4 a = (acc[ai][0][m][n] + ca1[n] * nm) * st.y + ca2[n], b = (acc[ai][1][m][n] + cb1[n] * nm) * st.y + cb2[n];
                    const float h0 = 16.0f * a[0] * fast_sigmoid(a[0]) * b[0], h1 = 16.0f * a[1] * fast_sigmoid(a[1]) * b[1], h2 = 16.0f * a[2] * fast_sigmoid(a[2]) * b[2], h3 = 16.0f * a[3] * fast_sigmoid(a[3]) * b[3];
                    unsigned x = 0u; x = __builtin_amdgcn_cvt_pk_fp8_f32(h0, h1, x, false); x = __builtin_amdgcn_cvt_pk_fp8_f32(h2, h3, x, true); if (n == 0) w.x = x; else w.y = x; }
                *(PG8_GAS u32x2e*)(HID + (size_t)(u.pm * BM + rl) * 5632 + u.pn * 128 + wc * 32 + 8 * fq) = w;
            }
    }
};

struct EpiPlain {
    static constexpr bool PERM = true, AFTER_DRAIN = false;
    PG8_GAS bf16_t* O;
    __device__ __forceinline__ void operator()(const f32x4 (&acc)[2][2][4][2], const Unit& u, int wr, int wc, int fr, int fq) const {
#pragma unroll
        for (int ai = 0; ai < 2; ++ai)
#pragma unroll
            for (int m = 0; m < 4; ++m) {
                const int row = u.pm * BM + ai * HALF + wr * 64 + m * 16 + fr;
#pragma unroll
                for (int bj = 0; bj < 2; ++bj)
                    *(PG8_GAS u32x4*)(O + (size_t)row * 2048 + u.pn * BM + bj * HALF + wc * 32 + 8 * fq) = pack8(acc[ai][bj][m][0], acc[ai][bj][m][1]);
            }
    }
};

struct EpiPleGate {
    static constexpr bool PERM = true, AFTER_DRAIN = false;
    const PG8_GAS _Float16* v2; const PG8_GAS bf16_t* PL; PG8_GAS _Float16* out; PG8_GAS float* outf; PG8_GAS bf16_t* outb; PG8_GAS unsigned char* outb8;
    const PG8_GAS f32x2e* ST; const PG8_GAS float* g2; const PG8_GAS float* b2; const PG8_GAS float* c1; const PG8_GAS float* c2; PG8_LAS unsigned char* lds; int tid;
    __device__ __forceinline__ void operator()(const f32x4 (&acc)[2][2][4][2], const Unit& u, int wr, int wc, int fr, int fq) const {
        typedef unsigned u32x2e __attribute__((ext_vector_type(2)));
        PG8_LAS f32x2e* tbl = (PG8_LAS f32x2e*)(lds + 133120);
        row_stats_table(ST, u.pm, tbl, tid);
        const int col0 = u.pn * BM + wc * 32 + 8 * fq;
#pragma unroll
        for (int bj = 0; bj < 2; ++bj) {
            const int col = col0 + bj * HALF;
            f32x4 gg[2], bb[2], k1[2], k2[2];
#pragma unroll
            for (int n = 0; n < 2; ++n) { gg[n] = *(const PG8_GAS f32x4*)(g2 + col + 4 * n); bb[n] = *(const PG8_GAS f32x4*)(b2 + col + 4 * n); k1[n] = *(const PG8_GAS f32x4*)(c1 + col + 4 * n); k2[n] = *(const PG8_GAS f32x4*)(c2 + col + 4 * n); }
#pragma unroll
            for (int ai = 0; ai < 2; ++ai)
#pragma unroll
                for (int mp = 0; mp < 2; ++mp) {
                    const int rl0 = ai * HALF + wr * 64 + mp * 32 + fr;
                    u32x4 pl[2]; f32x4 r[2][2];
#pragma unroll
                    for (int mm = 0; mm < 2; ++mm) { const size_t off = (size_t)(u.pm * BM + rl0 + mm * 16) * 2048 + col; pl[mm] = *(const PG8_GAS u32x4*)(PL + off); ld_h8(v2 + off, r[mm][0], r[mm][1]); }
                    asm volatile("" ::: "memory");
#pragma unroll
                    for (int mm = 0; mm < 2; ++mm) { const size_t off = (size_t)(u.pm * BM + rl0 + mm * 16) * 2048 + col; const int m = 2 * mp + mm; const f32x2e st = tbl[rl0 + mm * 16]; const float nm = -st.x;
                        f32x4 r0 = (r[mm][0] - st.x) * st.y * gg[0] + bb[0], r1 = (r[mm][1] - st.x) * st.y * gg[1] + bb[1];
                        const f32x4 a0 = (acc[ai][bj][m][0] + k1[0] * nm) * st.y + k2[0], a1 = (acc[ai][bj][m][1] + k1[1] * nm) * st.y + k2[1];
                        const u32x4 p = pl[mm];
                        r0[0] += bf_lo(p.x) * fast_sigmoid(a0[0]); r0[1] += bf_hi(p.x) * fast_sigmoid(a0[1]); r0[2] += bf_lo(p.y) * fast_sigmoid(a0[2]); r0[3] += bf_hi(p.y) * fast_sigmoid(a0[3]);
                        r1[0] += bf_lo(p.z) * fast_sigmoid(a1[0]); r1[1] += bf_hi(p.z) * fast_sigmoid(a1[1]); r1[2] += bf_lo(p.w) * fast_sigmoid(a1[2]); r1[3] += bf_hi(p.w) * fast_sigmoid(a1[3]);
                        if (outf) { *(PG8_GAS f32x4*)(outf + off) = r0; *(PG8_GAS f32x4*)(outf + off + 4) = r1; } else st_h8(out + off, r0, r1);
                        if (outf) continue;
                        *(PG8_GAS u32x4*)(outb + off) = pack8(r0, r1);
                        u32x2e w8; unsigned x = 0u; x = __builtin_amdgcn_cvt_pk_fp8_f32(r0[0], r0[1], x, false); x = __builtin_amdgcn_cvt_pk_fp8_f32(r0[2], r0[3], x, true); w8.x = x;
                        x = 0u; x = __builtin_amdgcn_cvt_pk_fp8_f32(r1[0], r1[1], x, false); x = __builtin_amdgcn_cvt_pk_fp8_f32(r1[2], r1[3], x, true); w8.y = x; *(PG8_GAS u32x2e*)(outb8 + off) = w8; }
                    asm volatile("" ::: "memory");
                }
        }
    }
};
template <class Epi> struct EpiKeeps { static __device__ __forceinline__ bool get(const Unit&) { return false; } };
template <> struct EpiKeeps<EpiBranchSeg> { static __device__ __forceinline__ bool get(const Unit& u) { return EpiBranchSeg::keeps(u); } };
template <class Epi> __device__ __forceinline__ bool epi_keeps_acc(const Unit& u) { return EpiKeeps<Epi>::get(u); }
template <class Epi, class Sched, bool ALIGN_EPI = false, bool SP2 = false, bool FP8 = false, class GemmT = Gemm>
__device__ __forceinline__ void gemm_phase(PG8_LAS unsigned char* lds, const GemmT g, const Sched& S, const Epi& E, const int wave_id) {
    int wid_ = wave_id; asm volatile("" : "+s"(wid_)); int lane_ = (int)__builtin_amdgcn_mbcnt_hi(~0u, __builtin_amdgcn_mbcnt_lo(~0u, 0u)); asm volatile("" : "+v"(lane_)); const int wid = wid_, lane = lane_, tid = wid * 64 + lane, wr = wid >> 2, wc = wid & 3, fr = lane & 15, fq = lane >> 4;
    const int K = gm_ld(g);
    unsigned voffA[2], voffB[2];
#pragma unroll
    for (int i = 0; i < 2; ++i) { int R, C; stage_rc(tid * 16 + i * 8192, R, C); const int Rb = Epi::PERM ? ((R & ~31) + perm32(R & 31)) : R;
        voffA[i] = (unsigned)(R * K + C) * 2u; voffB[i] = (unsigned)(Rb * K + C) * 2u; }
    const size_t kstep = (size_t)(BK * 2);
    const size_t hstep = (size_t)HALF * K * 2;
    const size_t tstep = 2 * hstep;
    const unsigned ldsw = (unsigned)wid * 1024u;
    const int aoff = lds_byte(wr * 64 + fr, fq * 8), boff = lds_byte(wc * 32 + fr, fq * 8);
#define PG8_SA(b, h) (((b) * 2 + (h)) * HTB)
#define PG8_SB(b, h) ((4 + (b) * 2 + (h)) * HTB)
#define PG8_STAGE(bufoff, gbase, voff) do { _Pragma("unroll") for (int _i = 0; _i < 2; ++_i) \
        __builtin_amdgcn_global_load_lds((const unsigned*)((const char*)(gbase) + (voff)[_i]), (PG8_LAS unsigned*)(lds + (bufoff) + ldsw + _i * 8192), 16, 0, 0); } while (0)
#define PG8_LDA(dst, b, h) do { if constexpr (FP8) { _Pragma("unroll") for (int m = 0; m < 4; ++m) { const v4i_t lo_ = *(const PG8_LAS v4i_t*)(lds + PG8_SA(b, h) + aoff + m * 2048), hi_ = *(const PG8_LAS v4i_t*)(lds + PG8_SA(b, h) + aoff + m * 2048 + 1024); dst##8[m] = __builtin_shufflevector(lo_, hi_, 0, 1, 2, 3, 4, 5, 6, 7); } } \
        else { _Pragma("unroll") for (int m = 0; m < 4; ++m) _Pragma("unroll") for (int k = 0; k < 2; ++k) dst[m][k] = *(const PG8_LAS bf16x8*)(lds + PG8_SA(b, h) + aoff + m * 2048 + k * 1024); } } while (0)
#define PG8_LDB(dst, b, h) do { if constexpr (FP8) { _Pragma("unroll") for (int n = 0; n < 2; ++n) { const v4i_t lo_ = *(const PG8_LAS v4i_t*)(lds + PG8_SB(b, h) + boff + n * 2048), hi_ = *(const PG8_LAS v4i_t*)(lds + PG8_SB(b, h) + boff + n * 2048 + 1024); dst##8[n] = __builtin_shufflevector(lo_, hi_, 0, 1, 2, 3, 4, 5, 6, 7); } } \
        else { _Pragma("unroll") for (int n = 0; n < 2; ++n) _Pragma("unroll") for (int k = 0; k < 2; ++k) dst[n][k] = *(const PG8_LAS bf16x8*)(lds + PG8_SB(b, h) + boff + n * 2048 + k * 1024); } } while (0)
#define PG8_MMA(ai, bj, At, Bt) do { __builtin_amdgcn_s_setprio(1); \
        if constexpr (FP8) { _Pragma("unroll") for (int m = 0; m < 4; ++m) _Pragma("unroll") for (int n = 0; n < 2; ++n) \
            asm volatile("v_mfma_scale_f32_16x16x128_f8f6f4 %0, %1, %2, %0, %3, %4 op_sel_hi:[0,0,0]" : "+v"(acc[ai][bj][m][n]) : "v"(Bt##8[n]), "v"(At##8[m]), "v"(sB_), "v"(sA_)); } \
        else { _Pragma("unroll") for (int m = 0; m < 4; ++m) _Pragma("unroll") for (int n = 0; n < 2; ++n) _Pragma("unroll") for (int k = 0; k < 2; ++k) \
            acc[ai][bj][m][n] = __builtin_amdgcn_mfma_f32_16x16x32_bf16(Bt[n][k], At[m][k], acc[ai][bj][m][n], 0, 0, 0); } \
        __builtin_amdgcn_s_setprio(0); } while (0)
#define PG8_WAIT_V(n) asm volatile("s_waitcnt vmcnt(" #n ")" ::: "memory")
#define PG8_WAIT_L(n) asm volatile("s_waitcnt lgkmcnt(" #n ")" ::: "memory")
#define PG8_BAR __builtin_amdgcn_s_barrier()
#define PG8_SCHED __builtin_amdgcn_sched_barrier(0)
    Unit cur, nxt; int ui = 0;
    if (!S.next(0, cur)) return;
    int nt = gm_nt(g, cur.seg);
    f32x4 acc[2][2][4][2];
#pragma unroll
    for (int a = 0; a < 2; ++a)
#pragma unroll
        for (int b = 0; b < 2; ++b)
#pragma unroll
            for (int m = 0; m < 4; ++m)
#pragma unroll
                for (int n = 0; n < 2; ++n) acc[a][b][m][n] = (f32x4){0.f, 0.f, 0.f, 0.f};
    int sA_ = 0, sB_ = 0;
    if constexpr (FP8) asm volatile("v_mov_b32 %0, %2\n\tv_mov_b32 %1, %3\n\ts_nop 7" : "=v"(sA_), "=v"(sB_) : "s"(g.sA), "s"(g.sB));
    bf16x8 At[4][2], B0[2][2], B1[2][2]; v8i_t At8[4], B08[2], B18[2];
    const char* cA = gm_a(g, cur.seg) + (size_t)cur.pm * tstep; const char* cB = gm_b(g, cur.seg) + (size_t)cur.pn * tstep;
    S.a_ready(cur);
    if constexpr (SP2) {
        PG8_STAGE(PG8_SB(0, 0), cB, voffB); PG8_STAGE(PG8_SB(0, 1), cB + hstep, voffB); PG8_STAGE(PG8_SA(0, 0), cA, voffA); PG8_STAGE(PG8_SA(0, 1), cA + hstep, voffA);
        if (wr == 1) PG8_BAR;
        PG8_WAIT_V(2); PG8_BAR;
        PG8_STAGE(PG8_SB(1, 0), cB + kstep, voffB); PG8_STAGE(PG8_SA(1, 0), cA + kstep, voffA); PG8_STAGE(PG8_SB(1, 1), cB + hstep + kstep, voffB);
        PG8_WAIT_V(6); PG8_BAR;
    } else {
        PG8_STAGE(PG8_SB(0, 0), cB, voffB); PG8_STAGE(PG8_SA(0, 0), cA, voffA); PG8_STAGE(PG8_SB(0, 1), cB + hstep, voffB); PG8_STAGE(PG8_SA(0, 1), cA + hstep, voffA);
        if (wr == 1) PG8_BAR;
        PG8_WAIT_V(4); PG8_BAR;
        PG8_STAGE(PG8_SB(1, 0), cB + kstep, voffB); PG8_STAGE(PG8_SA(1, 0), cA + kstep, voffA); PG8_STAGE(PG8_SB(1, 1), cB + hstep + kstep, voffB);
        PG8_WAIT_V(6); PG8_BAR;
    }
    for (;;) {
        const bool has_next = S.next(ui + 1, nxt);
        const char* nA = has_next ? gm_a(g, nxt.seg) + (size_t)nxt.pm * tstep : cA; const char* nB = has_next ? gm_b(g, nxt.seg) + (size_t)nxt.pn * tstep : cB;
        for (int t = 0; t < nt; t += 2) {
            const bool last = (t == nt - 2);
            const char* a1 = cA + (size_t)(t + 1) * kstep;
            const char* a2 = last ? nA : cA + (size_t)(t + 2) * kstep; const char* b2 = last ? nB : cB + (size_t)(t + 2) * kstep;
            const char* a3 = a2 + kstep; const char* b3 = b2 + kstep;
            if (last && has_next) S.a_ready(nxt);
            if constexpr (SP2) {
            PG8_LDB(B0, 0, 0); PG8_LDB(B1, 0, 1); PG8_SCHED; PG8_LDA(At, 0, 0); PG8_STAGE(PG8_SA(1, 1), a1 + hstep, voffA);
            PG8_WAIT_V(8); PG8_WAIT_L(0); PG8_BAR; PG8_MMA(0, 0, At, B0); PG8_MMA(0, 1, At, B1); PG8_BAR; PG8_SCHED;
            PG8_LDA(At, 0, 1); PG8_STAGE(PG8_SB(0, 0), b2, voffB); PG8_STAGE(PG8_SB(0, 1), b2 + hstep, voffB); PG8_STAGE(PG8_SA(0, 0), a2, voffA);
            PG8_WAIT_V(8); PG8_WAIT_L(0); PG8_BAR; PG8_MMA(1, 0, At, B0); PG8_MMA(1, 1, At, B1); PG8_BAR; PG8_SCHED;
            PG8_LDB(B0, 1, 0); PG8_LDB(B1, 1, 1); PG8_SCHED; PG8_LDA(At, 1, 0); PG8_STAGE(PG8_SA(0, 1), a2 + hstep, voffA);
            PG8_WAIT_V(8); PG8_WAIT_L(0); PG8_BAR; PG8_MMA(0, 0, At, B0); PG8_MMA(0, 1, At, B1); PG8_BAR; PG8_SCHED;
            PG8_LDA(At, 1, 1); PG8_STAGE(PG8_SB(1, 0), b3, voffB); PG8_STAGE(PG8_SB(1, 1), b3 + hstep, voffB); PG8_STAGE(PG8_SA(1, 0), a3, voffA);
            PG8_WAIT_V(8); PG8_WAIT_L(0); PG8_BAR; PG8_MMA(1, 0, At, B0); PG8_MMA(1, 1, At, B1); PG8_BAR; PG8_SCHED;
            } else {
            PG8_LDB(B0, 0, 0); PG8_SCHED; PG8_LDA(At, 0, 0); PG8_STAGE(PG8_SA(1, 1), a1 + hstep, voffA);
            PG8_WAIT_L(8); PG8_BAR; PG8_WAIT_L(0); PG8_MMA(0, 0, At, B0); PG8_BAR; PG8_SCHED;
            PG8_LDB(B1, 0, 1); PG8_STAGE(PG8_SB(0, 0), b2, voffB);
            PG8_BAR; PG8_WAIT_L(0); PG8_MMA(0, 1, At, B1); PG8_BAR;
            PG8_LDA(At, 0, 1); PG8_STAGE(PG8_SA(0, 0), a2, voffA);
            PG8_BAR; PG8_WAIT_L(0); PG8_MMA(1, 0, At, B0); PG8_BAR; PG8_SCHED;
            PG8_STAGE(PG8_SB(0, 1), b2 + hstep, voffB);
            PG8_WAIT_V(6); PG8_BAR; PG8_MMA(1, 1, At, B1); PG8_BAR;
            PG8_LDB(B0, 1, 0); PG8_SCHED; PG8_LDA(At, 1, 0); PG8_STAGE(PG8_SA(0, 1), a2 + hstep, voffA);
            PG8_WAIT_L(8); PG8_BAR; PG8_WAIT_L(0); PG8_MMA(0, 0, At, B0); PG8_BAR; PG8_SCHED;
            PG8_LDB(B1, 1, 1); PG8_STAGE(PG8_SB(1, 0), b3, voffB);
            PG8_BAR; PG8_WAIT_L(0); PG8_MMA(0, 1, At, B1); PG8_BAR;
            PG8_LDA(At, 1, 1); PG8_STAGE(PG8_SA(1, 0), a3, voffA);
            PG8_BAR; PG8_WAIT_L(0); PG8_MMA(1, 0, At, B0); PG8_BAR; PG8_SCHED;
            PG8_STAGE(PG8_SB(1, 1), b3 + hstep, voffB);
            PG8_WAIT_V(6); PG8_BAR; PG8_MMA(1, 1, At, B1); PG8_BAR;
            }
        }
        if constexpr (FP8) {
            asm volatile("s_nop 15\n\ts_nop 15\n\ts_nop 7" ::: "memory");
#pragma unroll
            for (int a_ = 0; a_ < 2; ++a_)
#pragma unroll
                for (int b_ = 0; b_ < 2; ++b_)
                    asm volatile("" : "+v"(acc[a_][b_][0][0]), "+v"(acc[a_][b_][0][1]), "+v"(acc[a_][b_][1][0]), "+v"(acc[a_][b_][1][1]), "+v"(acc[a_][b_][2][0]), "+v"(acc[a_][b_][2][1]), "+v"(acc[a_][b_][3][0]), "+v"(acc[a_][b_][3][1]));
        }
        if constexpr (ALIGN_EPI) { if (wr == 0) PG8_BAR; }
        if constexpr (!Epi::AFTER_DRAIN) { int fr2_ = fr, fq2_ = fq; asm volatile("" : "+v"(fr2_), "+v"(fq2_)); E(acc, cur, wr, wc, fr2_, fq2_); S.done(cur); }
        if (!has_next) break;
        if (!epi_keeps_acc<Epi>(cur)) {
#pragma unroll
        for (int a = 0; a < 2; ++a)
#pragma unroll
            for (int b = 0; b < 2; ++b)
#pragma unroll
                for (int m = 0; m < 4; ++m)
#pragma unroll
                    for (int n = 0; n < 2; ++n) acc[a][b][m][n] = (f32x4){0.f, 0.f, 0.f, 0.f};
        }
        cur = nxt; cA = nA; cB = nB; ++ui; nt = gm_nt(g, cur.seg);
        if constexpr (ALIGN_EPI) { if (wr == 1) PG8_BAR; }
    }
    PG8_WAIT_V(0);
    if constexpr (!ALIGN_EPI) { if (wr == 0) PG8_BAR; }
    PG8_BAR;
    if constexpr (Epi::AFTER_DRAIN) { E.fused(acc, cur, wr, wc, fr, fq, lds, wid, lane); S.done(cur); }
#undef PG8_SA
#undef PG8_SB
#undef PG8_STAGE
#undef PG8_LDA
#undef PG8_LDB
#undef PG8_MMA
#undef PG8_WAIT_V
#undef PG8_WAIT_L
#undef PG8_BAR
#undef PG8_SCHED
}
}
constexpr int NB = 4, SEQ = 2048, DM = 2048, NL = 4, MTOK = NB * SEQ;
constexpr int ZC = 12032, IN_COLS = 11874, DFF = 5632;
constexpr float ALPHA_F = 1.681792830507429f;
constexpr int NWAVES = 8;

constexpr size_t MiB = 1u << 20;
constexpr size_t WS_CTL = 0, CTL_ZERO_BYTES = 64 * 1024;
constexpr size_t WS_ROPE128 = 1 * MiB, WS_ROPE64 = 2 * MiB;
constexpr size_t WS_W = 3 * MiB, W_LAYER = 148 * MiB;
constexpr size_t WO_IN = 0;
constexpr size_t WO_ING8 = WO_IN + (size_t)5888 * 2048 * 2;
constexpr size_t WO_BRF = WO_IN + (size_t)ZC * 2048 * 2;
constexpr size_t WO_BRN = WO_BRF + 2048 * 768 * 2;
constexpr size_t WO_BRD = WO_BRN + 2048 * 768 * 2;
constexpr size_t WO_OUT = WO_BRD + 2048 * 768 * 2;
constexpr size_t WO_FFI = WO_OUT + 2048 * 2048 * 2;
constexpr size_t WO_FFO = WO_FFI + (size_t)11264 * 2048 * 2;
constexpr size_t WO_PG = WO_FFO + (size_t)2048 * 5632 * 2;
constexpr size_t WO_PI = WO_PG + 2048 * 2048 * 2;
constexpr size_t WO_CK1 = WO_PI + 2048 * 768 * 2;
constexpr size_t WO_CV1 = WO_CK1 + 256 * 4096 * 2;
constexpr size_t WO_CK2 = WO_CV1 + 256 * 4096 * 2;
constexpr size_t WO_CV2 = WO_CK2 + 128 * 256 * 2;
constexpr size_t WO_KVUP = WO_CV2 + 128 * 256 * 2;
constexpr size_t WO_END = WO_KVUP + 256 * 256 * 2;
static_assert(WO_END <= W_LAYER, "layer weight block");
constexpr size_t WS_ACT = WS_W + NL * W_LAYER;
constexpr size_t A_XB0 = WS_ACT, A_XB1 = A_XB0 + 32 * MiB;
constexpr size_t A_VA = A_XB1 + 32 * MiB;
constexpr size_t A_FQ = A_VA + 64 * MiB, A_FK = A_FQ + 12 * MiB, A_FV = A_FK + 12 * MiB;
constexpr size_t A_NQ = A_FV + 12 * MiB;
constexpr size_t A_KC = A_NQ + 8 * MiB, A_VC = A_KC + 2 * MiB, A_KS = A_VC + 2 * MiB, A_VS = A_KS + 2 * MiB, A_KW = A_VS + 2 * MiB, A_VW = A_KW + 2 * MiB;
constexpr size_t A_DQ = A_VW + 2 * MiB;
constexpr size_t A_CKV = A_DQ + 12 * MiB;
constexpr size_t A_IQ = A_CKV + 4 * MiB;
constexpr size_t A_IK = A_IQ + 16 * MiB;
constexpr size_t A_SM = A_IK + 1 * MiB;
constexpr size_t A_G = A_SM + 2 * MiB;
constexpr size_t A_HID = A_G;
constexpr size_t A_KD = A_G + 96 * MiB, A_VD = A_KD + 2 * MiB;
constexpr size_t A_SC = A_VD + 2 * MiB;
constexpr size_t A_MIXF = A_SC;
constexpr size_t A_BM = A_SC + 64 * MiB;
constexpr size_t A_HC = A_BM + 2 * MiB;
constexpr size_t A_KCMP = A_HC + 1 * MiB, A_VCMP = A_KCMP + 512 * 1024;
constexpr size_t A_OF = A_VCMP + 512 * 1024, A_ON = A_OF + 12 * MiB, A_OD = A_ON + 12 * MiB;
constexpr size_t A_MIXB = A_OD + 12 * MiB;
constexpr size_t A_PLB = A_MIXB + 32 * MiB;
constexpr size_t A_PB = A_PLB + 32 * MiB;
constexpr size_t A_OCS = A_PB + 48 * MiB;
constexpr size_t A_X8 = A_OCS + 16 * MiB;
constexpr size_t A_CBP = A_X8 + 16 * MiB;
constexpr size_t A_X8B = A_CBP + 1 * MiB;
constexpr size_t A_ST1 = A_X8B + 16 * MiB, A_ST2 = A_ST1 + 4 * MiB;
constexpr size_t A_CV = A_ST2 + 4 * MiB;
constexpr int CV_LAYER = 2 * 11264 + 2 * 2048;
constexpr size_t WS_END = A_CV + 1 * MiB;
constexpr int CW_TMO = 0, CW_CODE = 1;
constexpr int CW_Q = 64;
constexpr int CW_BAR = 4096;
constexpr int CW_CMPB = 8192;
constexpr int CW_FLAG = CW_CMPB + NL * 2 * 256;
static_assert((CW_FLAG + NL * 320) * 4 <= (int)CTL_ZERO_BYTES, "ctl");
constexpr int RING_OFF = 0, RING_BYTES = 131072;
constexpr int LDSCTL_OFF = 147456 - 1024, MISC_OFF = LDSCTL_OFF + 320;
constexpr int LDS_BYTES = 147456;
constexpr int LDS_STAT = 133120;

#define GAS __attribute__((address_space(1)))
#define LAS __attribute__((address_space(3)))
#define DI __device__ __forceinline__
typedef unsigned short bf16;
typedef unsigned v4u __attribute__((ext_vector_type(4)));
typedef unsigned v2u __attribute__((ext_vector_type(2)));
typedef float f32x4 __attribute__((ext_vector_type(4)));
typedef float f32x2 __attribute__((ext_vector_type(2)));
typedef float f32x16 __attribute__((ext_vector_type(16)));
typedef short bf16x8 __attribute__((ext_vector_type(8)));
typedef short s16x4 __attribute__((ext_vector_type(4)));
typedef GAS unsigned gu32;
#define RLX_AGENT __ATOMIC_RELAXED, __HIP_MEMORY_SCOPE_AGENT
#define LDS_WAIT() asm volatile("s_waitcnt lgkmcnt(0)" ::: "memory")
#define VM_WAIT() asm volatile("s_waitcnt vmcnt(0)" ::: "memory")
DI unsigned f2bf(float f) { unsigned u = __builtin_bit_cast(unsigned, f); return (u + 0x7fffu + ((u >> 16) & 1u)) >> 16; }
DI unsigned pk2(float lo, float hi) { return f2bf(lo) | (f2bf(hi) << 16); }
typedef __bf16 bf16x2_t __attribute__((ext_vector_type(2)));
DI unsigned cvtpk(float lo, float hi) { f32x2 v = {lo, hi}; bf16x2_t b = __builtin_convertvector(v, bf16x2_t); return __builtin_bit_cast(unsigned, b); }
DI float bfl(unsigned w) { return __uint_as_float(w << 16); }
DI float bfh(unsigned w) { return __uint_as_float(w & 0xffff0000u); }
DI float ex2(float x) { return __builtin_amdgcn_exp2f(x); }
DI float sigm(float x) { return __builtin_amdgcn_rcpf(1.0f + ex2(-1.4426950408889634f * x)); }
#define XB_TMO      128
#define XB_XCNT(j)  (256  + 64 * (j))
#define XB_XSUB(j)  (1280 + 64 * (j))
#define XB_XGEN(j)  (2304 + 64 * (j))
#define XB_TOP      3328
#define XB_TOPGEN   3392
#define XCD_BAR_WORDS 3456
#define XB_SPIN_CAP (1u << 18)

__device__ __forceinline__ unsigned xb_ld(unsigned* p)              { return __hip_atomic_load(p, __ATOMIC_RELAXED, __HIP_MEMORY_SCOPE_AGENT); }
__device__ __forceinline__ unsigned xb_add(unsigned* p, unsigned v) { return __hip_atomic_fetch_add(p, v, __ATOMIC_RELAXED, __HIP_MEMORY_SCOPE_AGENT); }
__device__ __forceinline__ unsigned xb_xcc_id() { return (unsigned)__builtin_amdgcn_s_getreg((3 << 11) | 20) & 0xFu; }
#define XB_SPIN(cond, bar) do { unsigned _sp = 0; while (cond) { __builtin_amdgcn_s_sleep(1); \
    if ((++_sp & 255u) == 0u) { if (xb_ld(&(bar)[XB_TMO])) break; if (_sp > XB_SPIN_CAP) { atomicAdd(&(bar)[XB_TMO], 1u); break; } } } } while (0)

struct XcdBarrier {
    unsigned* bar; unsigned x;
    volatile LAS unsigned* st;
};

__device__ __forceinline__ XcdBarrier xcd_barrier_post(unsigned* bar, volatile LAS unsigned* st) {
    XcdBarrier b; b.bar = bar; b.x = xb_xcc_id(); b.st = st;
    if (threadIdx.x == 0) (void)xb_add(&bar[XB_XCNT(b.x)], 1u);
    return b;
}
__device__ __forceinline__ void xcd_barrier_complete(unsigned* bar, unsigned x, unsigned& nloc, unsigned& nx) {
    const unsigned G = gridDim.x * gridDim.y * gridDim.z;
    unsigned sum, cnt, mine, sp = 0u;
    for (;;) {
        sum = 0u; cnt = 0u; mine = 0u;
#pragma unroll
        for (unsigned j = 0; j < 16; ++j) { const unsigned c = xb_ld(&bar[XB_XCNT(j)]); sum += c; cnt += (c > 0u) ? 1u : 0u; mine = (j == x) ? c : mine; }
        if (sum == G) break;
        __builtin_amdgcn_s_sleep(1);
        if ((++sp & 255u) == 0u) { if (xb_ld(&bar[XB_TMO])) break; if (sp > XB_SPIN_CAP) { atomicAdd(&bar[XB_TMO], 1u); break; } }
    }
    nloc = mine > 0u ? mine : 1u; nx = cnt > 0u ? cnt : 1u;
}

__device__ __forceinline__ void xcd_barrier(const XcdBarrier& b) {
    asm volatile("s_waitcnt vmcnt(0)" ::: "memory");
    __syncthreads();
    if (threadIdx.x == 0) {
        unsigned* bar = b.bar;
        __builtin_amdgcn_s_waitcnt(0);
        unsigned nloc = b.st[0], nx = b.st[1];
        if (nloc == 0u) { xcd_barrier_complete(bar, b.x, nloc, nx); b.st[0] = nloc; b.st[1] = nx; }
        const unsigned old = xb_add(&bar[XB_XSUB(b.x)], 1u);
        const unsigned gen = old / nloc;
        if (old + 1u == (gen + 1u) * nloc) {
            __builtin_amdgcn_fence(__ATOMIC_RELEASE, "agent");
            asm volatile("s_waitcnt vmcnt(0)" ::: "memory");
            const unsigned og = xb_add(&bar[XB_TOP], 1u);
            const unsigned tg = og / nx;
            if (og + 1u == (tg + 1u) * nx) xb_add(&bar[XB_TOPGEN], 1u);
            else XB_SPIN(xb_ld(&bar[XB_TOPGEN]) == tg, bar);
            __builtin_amdgcn_fence(__ATOMIC_ACQUIRE, "agent");
            xb_add(&bar[XB_XGEN(b.x)], 1u);
            asm volatile("s_waitcnt vmcnt(0)" ::: "memory");
        } else {
            XB_SPIN(xb_ld(&bar[XB_XGEN(b.x)]) == gen, bar);
            __builtin_amdgcn_fence(__ATOMIC_ACQUIRE, "agent");
            asm volatile("s_waitcnt vmcnt(0)" ::: "memory");
        }
    }
    __syncthreads();
}
struct Frame {
    LAS unsigned char* lds;
    volatile LAS unsigned* MISC;
    gu32* ctl;
    GAS unsigned char* ws;
    int tid, lane, wave;
    int vcu, G;
};
DI float wave_sum(float v) {
#pragma unroll
    for (int o = 1; o < 64; o <<= 1) v += __shfl_xor(v, o);
    return v;
}
DI int q_next(Frame& F, gu32* head) {
    if (F.tid == 0) F.MISC[4] = __hip_atomic_fetch_add(head, 1u, RLX_AGENT);
    __syncthreads();
    const int v = (int)F.MISC[4];
    __syncthreads();
    return v;
}

DI void unit_done(Frame& F, gu32* flag) {
    asm volatile("s_waitcnt vmcnt(0)" ::: "memory"); __syncthreads();
    if (F.tid == 0) { __builtin_amdgcn_fence(__ATOMIC_RELEASE, "agent"); asm volatile("s_waitcnt vmcnt(0)" ::: "memory"); (void)__hip_atomic_fetch_add(flag, 1u, RLX_AGENT); }
}
DI void unit_wait(Frame& F, gu32* f0, gu32* f1, unsigned need) {
    if (F.tid == 0) { unsigned* bar = (unsigned*)(F.ctl + CW_BAR);
        XB_SPIN(__hip_atomic_load(f0, RLX_AGENT) < need, bar); XB_SPIN(__hip_atomic_load(f1, RLX_AGENT) < need, bar);
        __builtin_amdgcn_fence(__ATOMIC_ACQUIRE, "agent"); asm volatile("s_waitcnt vmcnt(0)" ::: "memory"); }
    __syncthreads();
}
DI int deint128(int p) { return (p >> 1) + 64 * (p & 1); }
DI int deint64(int p) { return (p >> 1) + 32 * (p & 1); }
DI int win_src(int n) {
    if (n < 2304) return n;
    if (n < 2816) { const int p = n - 2304; return 2310 + (p & ~127) + deint128(p & 127); }
    if (n < 2944) return 2822 + (n - 2816);
    if (n < 3072) return 2950 + (n - 2944);
    if (n < 3200) return 3078 + deint128(n - 3072);
    if (n < 3328) return 3206 + (n - 3200);
    if (n < 3456) return 3334 + deint128(n - 3328);
    if (n < 3584) return 3462 + (n - 3456);
    if (n < 4352) { const int p = n - 3584; return 3602 + (p & ~127) + deint128(p & 127); }
    if (n < 4608) return 4370 + (n - 4352);
    if (n < 5632) { const int p = n - 4608; return 4626 + (p & ~63) + deint64(p & 63); }
    if (n < 5696) return 5650 + deint64(n - 5632);
    if (n < 5702) return 2304 + (n - 5696);
    if (n < 5714) return 3590 + (n - 5702);
    if (n < 5730) return 5714 + (n - 5714);
    if (n < 5888) return -1;
    return 5730 + (n - 5888);
}
DI unsigned pk4_fp8(float a, float b, float c, float d) { unsigned w = 0u; w = __builtin_amdgcn_cvt_pk_fp8_f32(a, b, w, false); w = __builtin_amdgcn_cvt_pk_fp8_f32(c, d, w, true); return w; }
DI int int128(int w) { return w < 64 ? 2 * w : 2 * (w - 64) + 1; }
DI int int64(int w) { return w < 32 ? 2 * w : 2 * (w - 32) + 1; }
DI int win_dst(int s) {
    if (s < 2304) return s;
    if (s < 2310) return 5696 + (s - 2304);
    if (s < 2822) { const int p = s - 2310; return 2304 + (p & ~127) + int128(p & 127); }
    if (s < 2950) return 2816 + (s - 2822);
    if (s < 3078) return 2944 + (s - 2950);
    if (s < 3206) return 3072 + int128(s - 3078);
    if (s < 3334) return 3200 + (s - 3206);
    if (s < 3462) return 3328 + int128(s - 3334);
    if (s < 3590) return 3456 + (s - 3462);
    if (s < 3602) return 5702 + (s - 3590);
    if (s < 4370) { const int p = s - 3602; return 3584 + (p & ~127) + int128(p & 127); }
    if (s < 4626) return 4352 + (s - 4370);
    if (s < 5650) { const int p = s - 4626; return 4608 + (p & ~63) + int64(p & 63); }
    if (s < 5714) return 5632 + int64(s - 5650);
    if (s < 5730) return s;
    return -1;
}
DI int dmap(int kind, int s) {
    if (kind == 0) return s;
    if (kind == 1 || kind == 6) {
        const int n = s < 5730 ? win_dst(s) : 5888 + (s - 5730); if (n < 0) return -1;
        const int t = n >> 8; const bool isa = t < 6 || t == 9 || t == 10 || (t >= 14 && t <= 16) || (t >= 18 && t <= 22);
        if (kind == 1) return isa ? ((t < 6 ? t : t < 11 ? t - 3 : t < 17 ? t - 6 : t - 7) << 8) + (n & 255) : -1;
        return isa ? -1 : ((t >= 23 ? t - 23 : t <= 8 ? t + 18 : t <= 13 ? t + 16 : 30) << 8) + (n & 255);
    }
    if (kind == 2) return s - 5730;
    if (kind == 3) { const int half = s >= DFF ? 1 : 0, j = s - half * DFF; return ((j >> 7) << 8) + half * 128 + (j & 127); }
    if (kind == 4) return int128(s);
    return s < 128 ? int128(s) : s;
}
typedef float f32x4u __attribute__((ext_vector_type(4), aligned(4)));
struct TrP { const GAS float* W; GAS unsigned char* WT; const GAS float* kscale; int Nsrc, k0, s0, ldw, kind; bool f8; float sc; bool skip; };
DI void tr_load(const TrP& t, int lane, f32x4 (&v)[16]) {
    const int kr = lane >> 4, c4 = lane & 15;
    const GAS float* src = t.W + (size_t)(t.k0 + kr) * t.Nsrc + t.s0 + 4 * c4;
#pragma unroll
    for (int i = 0; i < 16; ++i) v[i] = *(const GAS f32x4u*)(src + (size_t)(4 * i) * t.Nsrc);
}
DI void tr_finish(const TrP& t, const f32x4 (&v)[16], LAS float* scr, int lane) {
    const int kr = lane >> 4, c4 = lane & 15; const int k0 = t.k0, s0 = t.s0, ldw = t.ldw, kind = t.kind; const float sc = t.sc; const GAS float* kscale = t.kscale; GAS unsigned char* WT = t.WT;
#pragma unroll
    for (int i = 0; i < 16; ++i) { const float ks = kscale ? kscale[k0 + 4 * i + kr] * sc : sc; LAS float* d = scr + (4 * i + kr) * 65 + 4 * c4;
        d[0] = v[i][0] * ks; d[1] = v[i][1] * ks; d[2] = v[i][2] * ks; d[3] = v[i][3] * ks; }
    LDS_WAIT(); asm volatile("" ::: "memory");
    if (t.f8) {
#pragma unroll
        for (int p = 0; p < 4; ++p) { const int r = 16 * p + (lane >> 2), ch = lane & 3, n = dmap(kind, s0 + r); const LAS float* s = scr + (16 * ch) * 65 + r;
            v4u o; o.x = pk4_fp8(s[0], s[65], s[130], s[195]); o.y = pk4_fp8(s[260], s[325], s[390], s[455]); o.z = pk4_fp8(s[520], s[585], s[650], s[715]); o.w = pk4_fp8(s[780], s[845], s[910], s[975]);
            if (n >= 0) *(GAS v4u*)(WT + (size_t)n * ldw + k0 + 16 * ch) = o; }
    } else {
#pragma unroll
        for (int p = 0; p < 8; ++p) { const int r = 8 * p + (lane >> 3), ch = lane & 7, n = dmap(kind, s0 + r); const LAS float* s = scr + (8 * ch) * 65 + r;
            v4u o; o.x = cvtpk(s[0], s[65]); o.y = cvtpk(s[130], s[195]); o.z = cvtpk(s[260], s[325]); o.w = cvtpk(s[390], s[455]);
            if (n >= 0) *(GAS v4u*)(WT + ((size_t)n * ldw + k0 + 8 * ch) * 2) = o; }
    }
    LDS_WAIT(); asm volatile("" ::: "memory");
}
DI void sincos_d(double a, double& s, double& c) {
    const double k = __builtin_rint(a * 0.63661977236758134308);
    double r = a - k * 1.57079632679489655800e+00; r -= k * 6.12323399573676603587e-17;
    const double r2 = r * r;
    double sp = -7.6471637318198164759e-13; sp = sp * r2 + 1.6059043836821614599e-10; sp = sp * r2 - 2.5052108385441718775e-08; sp = sp * r2 + 2.7557319223985890653e-06;
    sp = sp * r2 - 1.9841269841269841270e-04; sp = sp * r2 + 8.3333333333333333333e-03; sp = sp * r2 - 1.6666666666666666667e-01; const double sr = r + r * r2 * sp;
    double cp = 4.7794773323873852974e-14; cp = cp * r2 - 1.1470745597729724714e-11; cp = cp * r2 + 2.0876756987868098979e-09; cp = cp * r2 - 2.7557319223985890653e-07;
    cp = cp * r2 + 2.4801587301587301587e-05; cp = cp * r2 - 1.3888888888888888889e-03; cp = cp * r2 + 4.1666666666666666667e-02; cp = cp * r2 - 0.5; const double cr = 1.0 + r2 * cp;
    const int q = ((int)k) & 3;
    s = (q == 0) ? sr : (q == 1) ? cr : (q == 2) ? -sr : -cr;
    c = (q == 0) ? cr : (q == 1) ? -sr : (q == 2) ? -cr : sr;
}
struct Args { const float* in[24]; float* out; unsigned char* ws; int pad0, pad1; };

constexpr int NIT = 2880 + 2880 + 3072 + 384 + 256 + 384 + 1024 + 5632 + 2816 + 1024 + 128 + 256 + 256 + 8 + 8 + 16;
static_assert(NIT == 16 * 1314, "a layer's items are dealt to 1314 workgroup units of 16 (two per wave)");
DI TrP conv_params(const Args& A, int l, int r) {
    const GAS float* W; int K, Nsrc, sbeg, nct, ldw, kind; bool f8 = false; float sc = 1.0f; size_t off; const GAS float* ksc = nullptr;
    if (r < 2880)           { W = (const GAS float*)A.in[2];  K = 2048; Nsrc = IN_COLS; sbeg = 0;    nct = 90;  ldw = 2048; kind = 1; off = WO_IN; }
    else if ((r -= 2880) < 2880) { W = (const GAS float*)A.in[2];  K = 2048; Nsrc = IN_COLS; sbeg = 0;    nct = 90;  ldw = 2048; kind = 6; off = WO_ING8; f8 = true; sc = 32.0f; }
    else if ((r -= 2880) < 3072) { W = (const GAS float*)A.in[2];  K = 2048; Nsrc = IN_COLS; sbeg = 5730; nct = 96;  ldw = 2048; kind = 6; off = WO_ING8; f8 = true; sc = 32.0f; }
    else if ((r -= 3072) < 384)  { W = (const GAS float*)A.in[12]; K = 768;  Nsrc = 2048; sbeg = 0; nct = 32;  ldw = 768;  kind = 0; off = WO_BRF; }
    else if ((r -= 384) < 256)   { W = (const GAS float*)A.in[13]; K = 512;  Nsrc = 2048; sbeg = 0; nct = 32;  ldw = 768;  kind = 0; off = WO_BRN; }
    else if ((r -= 256) < 384)   { W = (const GAS float*)A.in[14]; K = 768;  Nsrc = 2048; sbeg = 0; nct = 32;  ldw = 768;  kind = 0; off = WO_BRD; }
    else if ((r -= 384) < 1024)  { W = (const GAS float*)A.in[15]; K = 2048; Nsrc = 2048; sbeg = 0; nct = 32;  ldw = 2048; kind = 0; off = WO_OUT; }
    else if ((r -= 1024) < 5632) { W = (const GAS float*)A.in[18]; K = 2048; Nsrc = 11264; sbeg = 0; nct = 176; ldw = 2048; kind = 3; off = WO_FFI; f8 = true; sc = 64.0f; }
    else if ((r -= 5632) < 2816) { W = (const GAS float*)A.in[19]; K = 5632; Nsrc = 2048; sbeg = 0; nct = 32;  ldw = 5632; kind = 0; off = WO_FFO; f8 = true; sc = 128.0f; }
    else if ((r -= 2816) < 1024) { W = (const GAS float*)A.in[23]; K = 2048; Nsrc = 2048; sbeg = 0; nct = 32;  ldw = 2048; kind = 0; off = WO_PG; }
    else if ((r -= 1024) < 128)  { W = (const GAS float*)A.in[22]; K = 256;  Nsrc = 2048; sbeg = 0; nct = 32;  ldw = 768;  kind = 0; off = WO_PI; }
    else if ((r -= 128) < 256)   { W = (const GAS float*)A.in[6];  K = 4096; Nsrc = 256;  sbeg = 0; nct = 4;   ldw = 4096; kind = 0; off = WO_CK1; }
    else if ((r -= 256) < 256)   { W = (const GAS float*)A.in[8];  K = 4096; Nsrc = 256;  sbeg = 0; nct = 4;   ldw = 4096; kind = 0; off = WO_CV1; }
    else if ((r -= 256) < 8)     { W = (const GAS float*)A.in[7];  K = 256;  Nsrc = 128;  sbeg = 0; nct = 2;   ldw = 256;  kind = 4; off = WO_CK2; }
    else if ((r -= 8) < 8)       { W = (const GAS float*)A.in[9];  K = 256;  Nsrc = 128;  sbeg = 0; nct = 2;   ldw = 256;  kind = 0; off = WO_CV2; }
    else { r -= 8;         W = (const GAS float*)A.in[11]; K = 256;  Nsrc = 256;  sbeg = 0; nct = 4;   ldw = 256;  kind = 5; off = WO_KVUP; ksc = (const GAS float*)A.in[10] + (size_t)l * 256; }
    bool skip = false;
    if (kind == 1 || (kind == 6 && sbeg == 0)) {
        const int a = 64 * (r % nct), b = a + 63; const bool hit8 = (a < 2304 && b >= 1536) || (a < 3590 && b >= 2822) || (a < 4626 && b >= 4370);
        const bool all8 = (a >= 1536 && b < 2304) || (a >= 2822 && b < 3590) || (a >= 4370 && b < 4626);
        skip = kind == 1 ? all8 : !hit8;
    }
    TrP t; t.W = W + (size_t)l * K * Nsrc; t.skip = skip; t.WT = (GAS unsigned char*)A.ws + WS_W + (size_t)l * W_LAYER + off; t.kscale = ksc; t.Nsrc = Nsrc; t.k0 = 64 * (r / nct); t.s0 = sbeg + 64 * (r % nct); t.ldw = ldw; t.kind = kind; t.f8 = f8; t.sc = sc;
    return t;
}
DI void conv_one(const TrP& t, LAS float* scr, int lane) { f32x4 v[16]; tr_load(t, lane, v); tr_finish(t, v, scr, lane); }
DI void conv_item(Frame& F, const Args& A, int l, int r, LAS float* scr) { const TrP t = conv_params(A, l, r); if (!t.skip) conv_one(t, scr, F.lane); }
DI void conv_item2(Frame& F, const Args& A, int l, int r0, int r1, LAS float* scr) {
    const TrP t0 = conv_params(A, l, r0), t1 = conv_params(A, l, r1);
    if (t0.skip || t1.skip) { if (!t0.skip) conv_one(t0, scr, F.lane); if (!t1.skip) conv_one(t1, scr, F.lane); return; }
    f32x4 v0[16], v1[16];
    tr_load(t0, F.lane, v0); tr_load(t1, F.lane, v1);
    tr_finish(t0, v0, scr, F.lane); tr_finish(t1, v1, scr, F.lane);
}
DI void conv_unit(Frame& F, const Args& A, int l, int c) { conv_item2(F, A, l, c * 16 + F.wave, c * 16 + 8 + F.wave, (LAS float*)(F.lds + RING_OFF + F.wave * 16640)); }
DI void p0_prologue(Frame& F, const Args& A) {
    LAS float* scr = (LAS float*)(F.lds + RING_OFF + F.wave * 16640);
    const int gw = F.vcu * NWAVES + F.wave, NGW = F.G * NWAVES;
    for (int it = gw; it < NIT; it += 2 * NGW) { if (it + NGW < NIT) conv_item2(F, A, 0, it, it + NGW, scr); else conv_item(F, A, 0, it, scr); }
    for (int i = F.vcu * 512 + F.tid; i < NL * 158 * 256; i += F.G * 512) { const int l = i / (158 * 256), rr = i % (158 * 256);
        ((GAS v4u*)(F.ws + WS_W + (size_t)l * W_LAYER + WO_IN + (size_t)(15 * 256 + 98) * 4096))[rr] = (v4u){0u, 0u, 0u, 0u}; }
    const int gt = F.vcu * (NWAVES * 64) + F.tid, NGT = F.G * NWAVES * 64;
    for (int i = gt; i < SEQ * 96; i += NGT) {
        const bool big = i < SEQ * 64; const int ii = big ? i : i - SEQ * 64; const int pos = big ? (ii >> 6) : (ii >> 5), j = big ? (ii & 63) : (ii & 31);
        const double base = big ? 1.1547819846894583 : 1.3335214321633240;
        double t = 1.0; for (int e = 0; e < j; ++e) t *= base;
        const float inv = 1.0f / (float)t; const float ang = (float)pos * inv;
        double s, c; sincos_d((double)ang, s, c);
        GAS f32x2* dst = big ? (GAS f32x2*)(F.ws + WS_ROPE128) + ii : (GAS f32x2*)(F.ws + WS_ROPE64) + ii;
        *dst = (f32x2){(float)c, (float)s};
    }
    { const GAS f32x4* x4 = (const GAS f32x4*)A.in[0]; GAS v2u* o = (GAS v2u*)(F.ws + A_XB0); GAS unsigned* o8 = (GAS unsigned*)(F.ws + A_X8B);
      for (int i = gt; i < MTOK * DM / 4; i += NGT) { const f32x4 v = x4[i]; o[i] = (v2u){pk2(v[0], v[1]), pk2(v[2], v[3])}; o8[i] = pk4_fp8(v[0], v[1], v[2], v[3]);
          { typedef _Float16 h4 __attribute__((ext_vector_type(4))); ((GAS h4*)(F.ws + A_VA))[i] = __builtin_convertvector(v, h4); } }
      const GAS f32x4* p4 = (const GAS f32x4*)A.in[1]; GAS v2u* po = (GAS v2u*)(F.ws + A_PB);
      for (int i = gt; i < NL * MTOK * 256 / 4; i += NGT) { const f32x4 v = p4[i]; po[(size_t)(i >> 6) * 192 + (i & 63)] = (v2u){pk2(v[0], v[1]), pk2(v[2], v[3])}; } }
    for (int it = F.vcu; it < NL * 2 * 32; it += F.G) {
        const int l = it >> 6, kv = (it >> 5) & 1, kc = it & 31, n = F.tid & 255;
        if (F.tid < 256) {
            const GAS float* pe = (const GAS float*)(kv ? A.in[5] : A.in[4]) + (size_t)l * 4096 + kc * 128; const GAS float* w1 = (const GAS float*)(kv ? A.in[8] : A.in[6]) + ((size_t)l * 4096 + kc * 128) * 256 + n;
            float s = 0.f;
#pragma unroll 16
            for (int k = 0; k < 128; ++k) s += pe[k] * w1[(size_t)k * 256];
            ((GAS float*)(F.ws + A_CBP))[(size_t)it * 256 + n] = s;
        }
    }
}

DI void p0_cvec(Frame& F, const Args& A, int l) {
    const int gw = F.vcu * NWAVES + F.wave, NGW = F.G * NWAVES, lane = F.lane;
    GAS float* cv = (GAS float*)(F.ws + A_CV) + (size_t)l * CV_LAYER;
    {
        f32x4 g[8], bb[8];
        const GAS f32x4* g4 = (const GAS f32x4*)((const GAS float*)A.in[16] + (size_t)l * DM + 32 * lane); const GAS f32x4* b4 = (const GAS f32x4*)((const GAS float*)A.in[17] + (size_t)l * DM + 32 * lane);
#pragma unroll
        for (int i = 0; i < 8; ++i) { g[i] = g4[i]; bb[i] = b4[i]; }
        for (int base = gw; base < 11264; base += 6 * NGW) {
            v4u q[6][2];
#pragma unroll
            for (int k = 0; k < 6; ++k) { const int r = base + k * NGW; const GAS v4u* w = (const GAS v4u*)(F.ws + WS_W + (size_t)l * W_LAYER + WO_FFI + (size_t)(r < 11264 ? r : base) * 2048 + 32 * lane); q[k][0] = w[0]; q[k][1] = w[1]; }
#pragma unroll
            for (int k = 0; k < 6; ++k) { const int r = base + k * NGW; float s1 = 0.f, s2 = 0.f;
#pragma unroll
                for (int i = 0; i < 2; ++i)
#pragma unroll
                    for (int j = 0; j < 4; ++j) { const unsigned x = q[k][i][j]; const f32x2 lo = __builtin_amdgcn_cvt_pk_f32_fp8(x, false), hi = __builtin_amdgcn_cvt_pk_f32_fp8(x, true); const f32x4 gg = g[4 * i + j], bv = bb[4 * i + j];
                        s1 += (lo[0] * gg[0] + lo[1] * gg[1]) + (hi[0] * gg[2] + hi[1] * gg[3]); s2 += (lo[0] * bv[0] + lo[1] * bv[1]) + (hi[0] * bv[2] + hi[1] * bv[3]); }
                s1 = wave_sum(s1) * (1.0f / 64.0f); s2 = wave_sum(s2) * (1.0f / 64.0f);
                if (lane == 0 && r < 11264) { cv[r] = s1; cv[11264 + r] = s2; } }
        }
    }
    for (int c = gw; c < 2048; c += NGW) {
        const GAS f32x4* g4 = (const GAS f32x4*)((const GAS float*)A.in[20] + (size_t)l * DM + 32 * lane); const GAS f32x4* b4 = (const GAS f32x4*)((const GAS float*)A.in[21] + (size_t)l * DM + 32 * lane);
        const GAS v4u* w = (const GAS v4u*)(F.ws + WS_W + (size_t)l * W_LAYER + WO_PG + ((size_t)c * 2048 + 32 * lane) * 2);
        float s1 = 0.f, s2 = 0.f;
#pragma unroll
        for (int i = 0; i < 4; ++i) { const v4u q = w[i]; const f32x4 ga = g4[2 * i], gb = g4[2 * i + 1], ba = b4[2 * i], bb = b4[2 * i + 1];
            s1 += (bfl(q.x) * ga[0] + bfh(q.x) * ga[1]) + (bfl(q.y) * ga[2] + bfh(q.y) * ga[3]) + (bfl(q.z) * gb[0] + bfh(q.z) * gb[1]) + (bfl(q.w) * gb[2] + bfh(q.w) * gb[3]);
            s2 += (bfl(q.x) * ba[0] + bfh(q.x) * ba[1]) + (bfl(q.y) * ba[2] + bfh(q.y) * ba[3]) + (bfl(q.z) * bb[0] + bfh(q.z) * bb[1]) + (bfl(q.w) * bb[2] + bfh(q.w) * bb[3]); }
        s1 = wave_sum(s1); s2 = wave_sum(s2);
        if (lane == 0) { cv[22528 + c] = s1; cv[22528 + 2048 + c] = s2; }
    }
}

DI bool unit_poll(Frame& F, gu32* flag, unsigned need) {
    if (F.tid == 0) F.MISC[5] = __hip_atomic_load(flag, RLX_AGENT) >= need ? 1u : 0u;
    __syncthreads(); const bool r = F.MISC[5] != 0u; __syncthreads(); return r;
}
DI bool conv_try(Frame& F, const Args& A, int l, gu32* chead) {
    const int c = q_next(F, chead);
    if (c >= 1314) return false;
    conv_unit(F, A, l, c); return true;
}
template <bool OUT8> DI void ln_rows(Frame& F, const GAS float* in, GAS float* outf, GAS bf16* outb, const GAS float* g, const GAS float* b) {
    const int gw = F.vcu * NWAVES + F.wave, NGW = F.G * NWAVES;
    for (int m = gw; m < MTOK; m += NGW) {
        const GAS f32x4* xr = (const GAS f32x4*)(in + (size_t)m * DM) + F.lane;
        f32x4 v[8]; float s = 0.f;
#pragma unroll
        for (int j = 0; j < 8; ++j) { v[j] = xr[64 * j]; s += (v[j][0] + v[j][1]) + (v[j][2] + v[j][3]); }
        const float mean = wave_sum(s) * (1.f / DM); float s2 = 0.f;
#pragma unroll
        for (int j = 0; j < 8; ++j) { v[j] = v[j] - mean; s2 += (v[j][0] * v[j][0] + v[j][1] * v[j][1]) + (v[j][2] * v[j][2] + v[j][3] * v[j][3]); }
        const float rstd = 1.f / sqrtf(wave_sum(s2) * (1.f / DM) + 1e-5f);
        GAS f32x4* of = (GAS f32x4*)(outf + (size_t)m * DM) + F.lane; GAS v2u* ob = OUT8 ? (GAS v2u*)((GAS unsigned*)((GAS unsigned char*)outb + (size_t)m * DM) + F.lane) : (GAS v2u*)(outb + (size_t)m * DM) + F.lane;
#pragma unroll
        for (int j = 0; j < 8; ++j) { const f32x4 gg = ((const GAS f32x4*)g)[F.lane + 64 * j], bb = ((const GAS f32x4*)b)[F.lane + 64 * j]; const f32x4 o = v[j] * rstd * gg + bb;
            of[64 * j] = o; if (OUT8) ((GAS unsigned*)ob)[64 * j] = pk4_fp8(o[0], o[1], o[2], o[3]); else ob[64 * j] = (v2u){pk2(o[0], o[1]), pk2(o[2], o[3])}; }
    }
}

#define MFMA32(a, b, c) __builtin_amdgcn_mfma_f32_32x32x16_bf16((a), (b), (c), 0, 0, 0)
#define LADD(p, v) __hip_atomic_fetch_add((p), (v), __ATOMIC_RELAXED, __HIP_MEMORY_SCOPE_WORKGROUP)
namespace at {
constexpr int KSTR = 272, VSTR = 320, KBUF = 64 * KSTR, VBUF = 64 * VSTR;
constexpr int OFF_K0 = 0, OFF_K1 = KBUF, OFF_V0 = 2 * KBUF, OFF_V1 = 2 * KBUF + VBUF, OFF_K2 = 2 * KBUF + 2 * VBUF, OFF_V2 = OFF_K2 + KBUF, OFF_DUMMY = OFF_V2 + VBUF, OFF_MISC = OFF_DUMMY + 1024;
typedef unsigned long long u64;
struct KVRegs { v4u k0, k1, v0, v1; };
DI void kv_load(KVRegs& R, const GAS bf16* Kg, int pk, const GAS bf16* Vg, int pv, int row0, int maxrow, int tid) {
    const int r0 = tid >> 4, ch = tid & 15; int ra = row0 + r0, rb = row0 + r0 + 32; ra = ra > maxrow ? maxrow : ra; rb = rb > maxrow ? maxrow : rb;
    R.k0 = *(const GAS v4u*)(Kg + (size_t)ra * pk + ch * 8); R.k1 = *(const GAS v4u*)(Kg + (size_t)rb * pk + ch * 8);
    R.v0 = *(const GAS v4u*)(Vg + (size_t)ra * pv + ch * 8); R.v1 = *(const GAS v4u*)(Vg + (size_t)rb * pv + ch * 8);
}
DI void kv_store(LAS unsigned char* lds, int kofs, int vofs, const KVRegs& R, int tid) {
    const int r0 = tid >> 4, ch = tid & 15;
    *(LAS v4u*)(lds + kofs + r0 * KSTR + ch * 16) = R.k0; *(LAS v4u*)(lds + kofs + (r0 + 32) * KSTR + ch * 16) = R.k1;
    *(LAS v4u*)(lds + vofs + r0 * VSTR + ch * 16) = R.v0; *(LAS v4u*)(lds + vofs + (r0 + 32) * VSTR + ch * 16) = R.v1;
}
DI u64 range_mask(int lo, int hi) {
    if (hi < 0 || lo > 63 || lo > hi) return 0ull;
    const u64 hm = hi >= 63 ? ~0ull : ((1ull << (hi + 1)) - 1ull);
    const u64 lm = lo <= 0 ? ~0ull : (~0ull << lo);
    return hm & lm;
}
DI s16x4 vtr(LAS const unsigned char* p) { typedef short v4i16_t __attribute__((ext_vector_type(4))); return __builtin_bit_cast(s16x4, __builtin_amdgcn_ds_read_tr16_b64_v4i16((LAS v4i16_t*)p)); }
DI bf16x8 packp(const f32x16& x, int s8) {
    v4u p; p.x = cvtpk(x[s8], x[s8 + 1]); p.y = cvtpk(x[s8 + 2], x[s8 + 3]); p.z = cvtpk(x[s8 + 4], x[s8 + 5]); p.w = cvtpk(x[s8 + 6], x[s8 + 7]);
    return __builtin_bit_cast(bf16x8, p);
}
DI void mask_tile(f32x16& s0, f32x16& s1, u64 allow, int h) {
    const unsigned w0 = (unsigned)allow >> (4 * h), w1 = (unsigned)(allow >> 32) >> (4 * h);
#pragma unroll
    for (int r = 0; r < 16; ++r) {
        const unsigned pos = (r & 3) + 8 * (r >> 2); const unsigned NEG = __float_as_uint(-1e30f);
        const unsigned m0 = (unsigned)__builtin_amdgcn_sbfe((int)w0, pos, 1u), m1 = (unsigned)__builtin_amdgcn_sbfe((int)w1, pos, 1u);
        s0[r] = __uint_as_float((__float_as_uint(s0[r]) & m0) | (NEG & ~m0)); s1[r] = __uint_as_float((__float_as_uint(s1[r]) & m1) | (NEG & ~m1)); }
}
template <bool BIAS> DI void qk_tile(f32x16& s0, f32x16& s1, LAS const unsigned char* kbuf, const bf16x8 (&qf)[8], LAS const float* nbias, int lane, float negm = 0.f) {
    const int r32 = lane & 31, h = lane >> 5;
    if (BIAS) {
#pragma unroll
        for (int g = 0; g < 4; ++g) { const f32x4 b0 = *(LAS const f32x4*)(nbias + 8 * g + 4 * h), b1 = *(LAS const f32x4*)(nbias + 32 + 8 * g + 4 * h);
#pragma unroll
            for (int e = 0; e < 4; ++e) { s0[4 * g + e] = b0[e] + negm; s1[4 * g + e] = b1[e] + negm; } }
    } else {
#pragma unroll
        for (int r = 0; r < 16; ++r) { s0[r] = negm; s1[r] = negm; }
    }
    LAS const unsigned char* kp = kbuf + r32 * KSTR + h * 16;
#define KFRAG(i) (*(LAS const bf16x8*)(kp + ((i) & 1) * 32 * KSTR + ((i) >> 1) * 32))
    bf16x8 ka[4];
#pragma unroll
    for (int i = 0; i < 4; ++i) ka[i] = KFRAG(i);
    __builtin_amdgcn_sched_barrier(0);
#pragma unroll
    for (int i = 0; i < 16; ++i) {
        if (i & 1) s1 = MFMA32(ka[i & 3], qf[i >> 1], s1); else s0 = MFMA32(ka[i & 3], qf[i >> 1], s0);
        if (i + 4 < 16) ka[i & 3] = KFRAG(i + 4);
    }
#undef KFRAG
}
DI void pv_tile(f32x16 (&O)[4], LAS const unsigned char* vbuf, const f32x16& p0, const f32x16& p1, int lane) {
    const int h = lane >> 5;
    LAS const unsigned char* vp = vbuf + (4 * h + ((lane & 15) >> 2)) * VSTR + (16 * ((lane >> 4) & 1) + 4 * (lane & 3)) * 2;
#pragma unroll
    for (int kb = 0; kb < 2; ++kb)
#pragma unroll
        for (int s = 0; s < 2; ++s) {
            const bf16x8 pf = packp(kb ? p1 : p0, 8 * s);
#pragma unroll
            for (int db = 0; db < 4; ++db) {
                const s16x4 lo = vtr(vp + (kb * 32 + 16 * s) * VSTR + db * 64), hi = vtr(vp + (kb * 32 + 16 * s + 8) * VSTR + db * 64);
                const bf16x8 vf = __builtin_shufflevector(lo, hi, 0, 1, 2, 3, 4, 5, 6, 7);
                O[db] = MFMA32(vf, pf, O[db]);
            }
        }
}
template <bool BIAS> DI void attn_tile(LAS const unsigned char* kbuf, LAS const unsigned char* vbuf, const bf16x8 (&qf)[8], f32x16 (&O)[4], float& m, float& l, u64 allow, LAS const float* nbias, int lane) {
    const int h = lane >> 5;
    f32x16 s0, s1;
    qk_tile<BIAS>(s0, s1, kbuf, qf, nbias, lane, -m);
    if (!__all(allow == ~0ull)) mask_tile(s0, s1, allow, h);
    float mx = fmaxf(fmaxf(s0[0], s1[0]), fmaxf(s0[1], s1[1]));
#pragma unroll
    for (int r = 2; r < 16; r += 2) mx = fmaxf(mx, fmaxf(fmaxf(s0[r], s1[r]), fmaxf(s0[r + 1], s1[r + 1])));
    mx = fmaxf(mx, __shfl_xor(mx, 32));
    if (__any(mx > 8.0f)) {
        const float dl = fmaxf(mx, 0.f), alpha = ex2(-dl); l *= alpha; m += dl;
#pragma unroll
        for (int r = 0; r < 16; ++r) { s0[r] -= dl; s1[r] -= dl; }
#pragma unroll
        for (int d = 0; d < 4; ++d)
#pragma unroll
            for (int r = 0; r < 16; ++r) O[d][r] *= alpha;
    }
    float sum = 0.f;
#pragma unroll
    for (int r = 0; r < 16; ++r) { s0[r] = ex2(s0[r]); sum += s0[r]; }
    {
        const int h = lane >> 5;
        LAS const unsigned char* vp = vbuf + (4 * h + ((lane & 15) >> 2)) * VSTR + (16 * ((lane >> 4) & 1) + 4 * (lane & 3)) * 2;
#pragma unroll
        for (int kb = 0; kb < 2; ++kb)
#pragma unroll
            for (int s = 0; s < 2; ++s) {
                const bf16x8 pf = packp(kb ? s1 : s0, 8 * s);
#pragma unroll
                for (int db = 0; db < 4; ++db) {
                    const s16x4 lo = vtr(vp + (kb * 32 + 16 * s) * VSTR + db * 64), hi = vtr(vp + (kb * 32 + 16 * s + 8) * VSTR + db * 64);
                    const bf16x8 vf = __builtin_shufflevector(lo, hi, 0, 1, 2, 3, 4, 5, 6, 7);
                    O[db] = MFMA32(vf, pf, O[db]);
                    if (kb == 0) { const int r = 2 * (4 * s + db); s1[r] = ex2(s1[r]); s1[r + 1] = ex2(s1[r + 1]); sum += s1[r] + s1[r + 1]; }
                }
            }
    }
    l += sum;
}
DI void glds16(const GAS void* gsrc, unsigned lds_dst) { unsigned keep;
    asm volatile("s_mov_b32 %0, m0\n\ts_mov_b32 m0, %2\n\ts_nop 0\n\tglobal_load_lds_dwordx4 %1, off\n\ts_mov_b32 m0, %0" : "=&s"(keep) : "v"(gsrc), "s"(lds_dst) : "memory"); }
template <bool BIAS, bool D2, class AllowF> DI void attn_pass(LAS unsigned char* lds, const GAS bf16* Kg, int pk, const GAS bf16* Vg, int pv, int maxrow, unsigned tset,
                                                       const bf16x8 (&qf)[8], f32x16 (&O)[4], float& m, float& l, const AllowF& allowf, LAS const float* nbias, int tid, int lane) {
    if (tset == 0u) return;
    const int wave = __builtin_amdgcn_readfirstlane(tid >> 6);
    const unsigned lds0 = (unsigned)(size_t)lds;
    unsigned doff[5];
#pragma unroll
    for (int k = 0; k < 5; ++k) { const int q = wave + 8 * k;
        if (q < 17) { const int c = 64 * q + lane, r = c / 17, col = c - 17 * r; doff[k] = (unsigned)(r * pk * 2 + (col < 16 ? col : 15) * 16); }
        else if (q < 37) { const int c = 64 * (q - 17) + lane, r = c / 20, col = c - 20 * r; doff[k] = (unsigned)(r * pv * 2 + (col < 16 ? col : 15) * 16); }
        else doff[k] = (unsigned)((lane & 15) * 16); }
#define ISSUE_TILE(jt, slot) do { const GAS unsigned char* kb_ = (const GAS unsigned char*)(Kg + (size_t)(64 * (jt)) * pk); const GAS unsigned char* vb_ = (const GAS unsigned char*)(Vg + (size_t)(64 * (jt)) * pv); \
        const unsigned ko_ = lds0 + ((slot) == 0 ? OFF_K0 : (slot) == 1 ? OFF_K1 : OFF_K2), vo_ = lds0 + ((slot) == 0 ? OFF_V0 : (slot) == 1 ? OFF_V1 : OFF_V2); \
        _Pragma("unroll") for (int k = 0; k < 5; ++k) { const int q = wave + 8 * k; \
            if (q < 17) glds16(kb_ + doff[k], (unsigned)__builtin_amdgcn_readfirstlane(ko_ + 1024 * q)); \
            else if (q < 37) glds16(vb_ + doff[k], (unsigned)__builtin_amdgcn_readfirstlane(vo_ + 1024 * (q - 17))); \
            else glds16(kb_ + doff[k], (unsigned)__builtin_amdgcn_readfirstlane(lds0 + OFF_DUMMY)); } } while (0)
    int j = __builtin_ctz(tset); tset &= tset - 1u;
    u64 raw = allowf.pre(j);
    ISSUE_TILE(j, 0);
    bool more = tset != 0u; int jn = 0; u64 rawn = 0ull;
    if (more) { jn = __builtin_ctz(tset); tset &= tset - 1u; rawn = allowf.pre(jn); ISSUE_TILE(jn, 1); asm volatile("s_waitcnt vmcnt(5)\n\ts_barrier" ::: "memory"); }
    else asm volatile("s_waitcnt vmcnt(0)\n\ts_barrier" ::: "memory");
    int s0 = 0, s1 = 1, s2 = 2;
    for (;;) {
        const bool more2 = more && tset != 0u; int jn2 = 0; u64 rawn2 = 0ull;
        if (more2) { jn2 = __builtin_ctz(tset); tset &= tset - 1u; rawn2 = allowf.pre(jn2); ISSUE_TILE(jn2, s2); }
        const u64 allow = allowf.make(j, raw);
        if (__any(allow != 0ull)) attn_tile<BIAS>(lds + (s0 == 0 ? OFF_K0 : s0 == 1 ? OFF_K1 : OFF_K2), lds + (s0 == 0 ? OFF_V0 : s0 == 1 ? OFF_V1 : OFF_V2), qf, O, m, l, allow, nbias + 64 * j, lane);
        if (more2) asm volatile("s_waitcnt vmcnt(5) lgkmcnt(0)\n\ts_barrier" ::: "memory");
        else asm volatile("s_waitcnt vmcnt(0) lgkmcnt(0)\n\ts_barrier" ::: "memory");
        if (!more) break;
        j = jn; raw = rawn; jn = jn2; rawn = rawn2; more = more2;
        const int t_ = s0; s0 = s1; s1 = s2; s2 = t_;
    }
#undef ISSUE_TILE
}
DI unsigned tile_range(int j0, int j1) {
    if (j1 <= j0) return 0u;
    const unsigned hi = j1 >= 32 ? ~0u : ((1u << j1) - 1u); return hi & ~((1u << j0) - 1u);
}
DI void load_q(bf16x8 (&qf)[8], const GAS bf16* Qrow, int lane) {
#pragma unroll
    for (int ks = 0; ks < 8; ++ks) qf[ks] = *(const GAS bf16x8*)(Qrow + ks * 16 + (lane >> 5) * 8);
}
DI void store_o(GAS bf16* Orow, const f32x16 (&O)[4], float sc, int lane) {
    const int h = lane >> 5;
#pragma unroll
    for (int db = 0; db < 4; ++db)
#pragma unroll
        for (int g = 0; g < 4; ++g) { v2u w; w.x = cvtpk(O[db][4 * g] * sc, O[db][4 * g + 1] * sc); w.y = cvtpk(O[db][4 * g + 2] * sc, O[db][4 * g + 3] * sc);
            *(GAS v2u*)(Orow + 32 * db + 8 * g + 4 * h) = w; }
}
struct AllowCausal { int q; DI u64 pre(int) const { return 0ull; } DI u64 make(int j, u64) const { return range_mask(0, q - 64 * j); } DI u64 rng(int j) const { return range_mask(0, q - 64 * j); } };
struct AllowWin { int q; DI u64 pre(int) const { return 0ull; } DI u64 make(int j, u64) const { return range_mask(q - 511 - 64 * j, q - 64 * j); } DI u64 rng(int j) const { return range_mask(q - 511 - 64 * j, q - 64 * j); } };
struct AllowSlc { int q; unsigned sel; DI u64 pre(int) const { return 0ull; } DI u64 make(int j, u64) const { return ((sel >> j) & 1u) ? range_mask(0, q - 64 * j) : 0ull; } DI u64 rng(int j) const { return ((sel >> j) & 1u) ? range_mask(0, q - 64 * j) : 0ull; } };
struct AllowDsa { int q; const GAS u64* bm; DI u64 pre(int j) const { return bm[j]; } DI u64 make(int j, u64 raw) const { return raw & range_mask(0, q - 64 * j); } DI u64 rng(int j) const { return range_mask(0, q - 64 * j); } };
}

DI void fox_unit(Frame& F, const GAS float* fbias_l, int b, int hd, int qb) {
    using namespace at;
    LAS unsigned char* lds = F.lds; const int tid = F.tid, lane = F.lane, wave = F.wave;
    LAS float* ncum = (LAS float*)(lds + OFF_MISC);
    LAS float* wtot = (LAS float*)(lds + OFF_MISC + 8192);
    const GAS float* SM = (const GAS float*)(F.ws + A_SM);
    const int n = 256 * (qb + 1);
    {
        const float fb = fbias_l[hd]; float v[4]; float run = 0.f;
#pragma unroll
        for (int e = 0; e < 4; ++e) { const int t = tid * 4 + e; float ls = 0.f;
            if (t < n) { const float x = SM[(size_t)(b * SEQ + t) * 64 + hd] + fb; ls = fminf(x, 0.f) - __logf(1.0f + __expf(-fabsf(x))); }
            run += ls; v[e] = run; }
        float inc = run;
#pragma unroll
        for (int o = 1; o < 64; o <<= 1) { const float t = __shfl_up(inc, o); if (lane >= o) inc += t; }
        if (lane == 63) wtot[wave] = inc;
        __syncthreads();
        float base = inc - run;
        for (int w = 0; w < wave; ++w) base += wtot[w];
#pragma unroll
        for (int e = 0; e < 4; ++e) ncum[tid * 4 + e] = -(base + v[e]) * 1.4426950408889634f;
        __syncthreads();
    }
    const int q0 = 256 * qb + 32 * wave, q = q0 + (lane & 31); const size_t qrow = (size_t)b * SEQ + q;
    bf16x8 qf[8]; load_q(qf, (const GAS bf16*)(F.ws + A_FQ) + qrow * 768 + hd * 128, lane);
    f32x16 O[4];
#pragma unroll
    for (int d = 0; d < 4; ++d)
#pragma unroll
        for (int r = 0; r < 16; ++r) O[d][r] = 0.f;
    float m = 0.f, l = 0.f;
    const GAS bf16* Kg = (const GAS bf16*)(F.ws + A_FK) + (size_t)b * SEQ * 768 + hd * 128; const GAS bf16* Vg = (const GAS bf16*)(F.ws + A_FV) + (size_t)b * SEQ * 768 + hd * 128;
    attn_pass<true, true>(lds, Kg, 768, Vg, 768, SEQ - 1, tile_range(0, 4 * (qb + 1)), qf, O, m, l, AllowCausal{q}, ncum, tid, lane);
    const float lt = l + __shfl_xor(l, 32);
    store_o((GAS bf16*)(F.ws + A_OF) + qrow * 768 + hd * 128, O, lt > 0.f ? 1.0f / lt : 0.f, lane);
}

DI void indexer_unit(Frame& F, int b, int qb, int kb) {
    LAS unsigned char* lds = F.lds; const int tid = F.tid, lane = F.lane, wave = F.wave, r32 = lane & 31, h = lane >> 5;
    constexpr int ISTR = 144;
    {
        const GAS bf16* IK = (const GAS bf16*)(F.ws + A_IK) + ((size_t)b * SEQ + 256 * kb) * 64;
#pragma unroll
        for (int i = 0; i < 4; ++i) { const int idx = tid + 512 * i, row = idx >> 3, ch = idx & 7; *(LAS v4u*)(lds + row * ISTR + ch * 16) = *(const v4u*)(IK + (size_t)row * 64 + ch * 8); }
    }
    __syncthreads();
    const int q0 = 256 * qb + 32 * wave, q = q0 + r32; const size_t qrow = (size_t)b * SEQ + q;
    const int nblk = (kb < qb) ? 8 : (wave + 1);
    const GAS bf16* IQ = (const GAS bf16*)(F.ws + A_IQ) + qrow * 1024 + h * 8; const GAS float* wq = (const GAS float*)(F.ws + A_SM) + qrow * 64 + 18;
    GAS float* SC = (GAS float*)(F.ws + A_SC) + qrow * SEQ + 256 * kb + 4 * h;
    for (int kh = 0; kh < 2; ++kh) {
        if (4 * kh >= nblk) break;
        f32x16 acc[4];
#pragma unroll
        for (int k = 0; k < 4; ++k)
#pragma unroll
            for (int r = 0; r < 16; ++r) acc[k][r] = 0.f;
        bf16x8 kf[4][4];
#pragma unroll
        for (int k = 0; k < 4; ++k)
#pragma unroll
            for (int ks = 0; ks < 4; ++ks) kf[k][ks] = *(LAS const bf16x8*)(lds + (128 * kh + 32 * k + r32) * ISTR + h * 16 + ks * 32);
        bf16x8 qf[4], qn[4]; float w, wn;
#pragma unroll
        for (int ks = 0; ks < 4; ++ks) qf[ks] = *(const bf16x8*)(IQ + ks * 16);
        w = wq[0] * 0.03125f;
        for (int hd = 0; hd < 16; ++hd) {
            const int hn = hd < 15 ? hd + 1 : 15;
#pragma unroll
            for (int ks = 0; ks < 4; ++ks) qn[ks] = *(const bf16x8*)(IQ + hn * 64 + ks * 16);
            wn = wq[hn] * 0.03125f;
#pragma unroll
            for (int k = 0; k < 4; ++k) {
                if (4 * kh + k < nblk) {
                    f32x16 s = {};
#pragma unroll
                    for (int ks = 0; ks < 4; ++ks) s = MFMA32(kf[k][ks], qf[ks], s);
#pragma unroll
                    for (int r = 0; r < 16; ++r) acc[k][r] += w * fmaxf(s[r], 0.f);
                }
            }
#pragma unroll
            for (int ks = 0; ks < 4; ++ks) qf[ks] = qn[ks];
            w = wn;
        }
#pragma unroll
        for (int k = 0; k < 4; ++k)
            if (4 * kh + k < nblk) {
#pragma unroll
                for (int g = 0; g < 4; ++g) *(f32x4*)(SC + 128 * kh + 32 * k + 8 * g) = (f32x4){acc[k][4 * g], acc[k][4 * g + 1], acc[k][4 * g + 2], acc[k][4 * g + 3]};
            }
    }
    __syncthreads();
}

DI void kvup_unit(Frame& F, const GAS bf16* Wt, int u) {
    const int lane = F.lane, wave = F.wave, r32 = lane & 31, h = lane >> 5;
    bf16x8 af[16];
    const GAS bf16* wrow = Wt + (size_t)(32 * wave + r32) * 256 + h * 8;
#pragma unroll
    for (int ks = 0; ks < 16; ++ks) af[ks] = *(const bf16x8*)(wrow + ks * 16);
    const GAS f32x2* rope = (const GAS f32x2*)(F.ws + WS_ROPE128);
    for (int tb = 0; tb < 4; ++tb) {
        const int m = 128 * u + 32 * tb + r32; const GAS bf16* xr = (const GAS bf16*)(F.ws + A_CKV) + (size_t)m * 256 + h * 8;
        f32x16 d; float ss = 0.f;
#pragma unroll
        for (int r = 0; r < 16; ++r) d[r] = 0.f;
#pragma unroll
        for (int ks = 0; ks < 16; ++ks) { const bf16x8 bfr = *(const bf16x8*)(xr + ks * 16); const v4u w = __builtin_bit_cast(v4u, bfr);
            ss += bfl(w.x) * bfl(w.x) + bfh(w.x) * bfh(w.x) + bfl(w.y) * bfl(w.y) + bfh(w.y) * bfh(w.y) + bfl(w.z) * bfl(w.z) + bfh(w.z) * bfh(w.z) + bfl(w.w) * bfl(w.w) + bfh(w.w) * bfh(w.w);
            d = MFMA32(af[ks], bfr, d); }
        ss += __shfl_xor(ss, 32);
        const float rstd = 1.0f / sqrtf(ss * (1.0f / 256.0f) + 1e-6f);
        const int pos = m & (SEQ - 1);
        GAS bf16* dst = (wave < 4) ? (GAS bf16*)(F.ws + A_KD) + (size_t)m * 128 + 32 * wave : (GAS bf16*)(F.ws + A_VD) + (size_t)m * 128 + 32 * (wave - 4);
#pragma unroll
        for (int g = 0; g < 4; ++g) {
            float v0 = d[4 * g] * rstd, v1 = d[4 * g + 1] * rstd, v2 = d[4 * g + 2] * rstd, v3 = d[4 * g + 3] * rstd;
            if (wave < 4) { const f32x4 cs = *(const f32x4*)(rope + (size_t)pos * 64 + 16 * wave + 4 * g + 2 * h);
                const float a0 = v0 * cs[0] - v1 * cs[1], a1 = v0 * cs[1] + v1 * cs[0], a2 = v2 * cs[2] - v3 * cs[3], a3 = v2 * cs[3] + v3 * cs[2]; v0 = a0; v1 = a1; v2 = a2; v3 = a3; }
            *(v2u*)(dst + 8 * g + 4 * h) = (v2u){cvtpk(v0, v1), cvtpk(v2, v3)};
        }
    }
}

DI void compress1_unit(Frame& F, const GAS unsigned char* wl, int l, int u) {
    const int lane = F.lane, wave = F.wave, r32 = lane & 31, h = lane >> 5;
    const int kv = u >> 5, rb = (u >> 1) & 15, chh = u & 1, R0 = 32 * rb, n0 = 128 * chh + 32 * (wave & 3), kh = wave >> 2;
    const int mrow = R0 + r32, bb = mrow >> 7, c = mrow & 127;
    const GAS bf16* ar = (const GAS bf16*)(F.ws + (kv ? A_VC : A_KC)) + ((size_t)bb * SEQ + 16 * c) * 128 + 2048 * kh + h * 8;
    const GAS bf16* br = (const GAS bf16*)(wl + (kv ? WO_CV1 : WO_CK1)) + (size_t)(n0 + r32) * 4096 + 2048 * kh + h * 8;
    f32x16 d;
#pragma unroll
    for (int r = 0; r < 16; ++r) d[r] = 0.f;
    for (int k0 = 0; k0 < 2048; k0 += 128) {
        bf16x8 a[8], bq[8];
#pragma unroll
        for (int i = 0; i < 8; ++i) { a[i] = *(const GAS bf16x8*)(ar + k0 + 16 * i); bq[i] = *(const GAS bf16x8*)(br + k0 + 16 * i); }
#pragma unroll
        for (int i = 0; i < 8; ++i) d = MFMA32(a[i], bq[i], d);
    }
    LAS float* xch = (LAS float*)F.lds + (wave & 3) * 1024;
    if (kh == 1) {
#pragma unroll
        for (int r = 0; r < 16; ++r) xch[r * 64 + lane] = d[r];
    }
    __syncthreads();
    if (kh == 0) {
        float bias = 0.f; { const GAS float* cbp = (const GAS float*)(F.ws + A_CBP) + (size_t)(l * 2 + kv) * 32 * 256 + n0 + r32;
#pragma unroll 8
            for (int kc = 0; kc < 32; ++kc) bias += cbp[kc * 256]; }
        GAS bf16* HC = (GAS bf16*)(F.ws + A_HC) + (size_t)kv * 512 * 256 + n0 + r32;
#pragma unroll
        for (int r = 0; r < 16; ++r) {
            const int row = R0 + (r & 3) + 8 * (r >> 2) + 4 * h; const float x = d[r] + xch[r * 64 + lane] + bias;
            const float t = 0.7978845608028654f * (x + 0.044715f * x * x * x); const float th = 1.0f - 2.0f * __builtin_amdgcn_rcpf(1.0f + __expf(2.0f * t));
            HC[(size_t)row * 256] = (bf16)f2bf(0.5f * x * (1.0f + th));
        }
    }
    __syncthreads();
}
DI void compress2_unit(Frame& F, const GAS unsigned char* wl, int u) {
    const int lane = F.lane, wave = F.wave, r32 = lane & 31, h = lane >> 5;
    const int kv = u >> 3, wb = (u & 7) * 8 + wave, cblk = wb >> 2, nblk = wb & 3;
    const GAS bf16* ar = (const GAS bf16*)(wl + (kv ? WO_CV2 : WO_CK2)) + (size_t)(32 * nblk + r32) * 256 + h * 8;
    const int row = 32 * cblk + r32;
    const GAS bf16* br = (const GAS bf16*)(F.ws + A_HC) + ((size_t)kv * 512 + row) * 256 + h * 8;
    f32x16 d;
#pragma unroll
    for (int r = 0; r < 16; ++r) d[r] = 0.f;
#pragma unroll
    for (int ks = 0; ks < 16; ++ks) d = MFMA32(*(const bf16x8*)(ar + ks * 16), *(const bf16x8*)(br + ks * 16), d);
    const int c = row & 127; int pos = 16 * c + 31; pos = pos > SEQ - 1 ? SEQ - 1 : pos;
    const GAS f32x2* rope = (const GAS f32x2*)(F.ws + WS_ROPE128);
    GAS bf16* dst = (GAS bf16*)(F.ws + (kv ? A_VCMP : A_KCMP)) + (size_t)row * 128 + 32 * nblk;
#pragma unroll
    for (int g = 0; g < 4; ++g) {
        float v0 = d[4 * g], v1 = d[4 * g + 1], v2 = d[4 * g + 2], v3 = d[4 * g + 3];
        if (kv == 0) { const f32x4 cs = *(const f32x4*)(rope + (size_t)pos * 64 + 16 * nblk + 4 * g + 2 * h);
            const float a0 = v0 * cs[0] - v1 * cs[1], a1 = v0 * cs[1] + v1 * cs[0], a2 = v2 * cs[2] - v3 * cs[3], a3 = v2 * cs[3] + v3 * cs[2]; v0 = a0; v1 = a1; v2 = a2; v3 = a3; }
        *(v2u*)(dst + 8 * g + 4 * h) = (v2u){cvtpk(v0, v1), cvtpk(v2, v3)};
    }
}

DI void sel_load(unsigned (&v)[32], const GAS float* sc, int t, int lane) {
    const int ntl = (t >> 6) + 1;
#pragma unroll
    for (int i = 0; i < 32; ++i) {
        unsigned key = 0u;
        if (i < ntl) { const int kx = 64 * i + lane; if (kx <= t) { const unsigned fb = __float_as_uint(sc[kx]); key = (fb & 0x80000000u) ? ~fb : (fb | 0x80000000u); } }
        v[i] = key;
    }
}
template <int NR> DI int wave_count_ge(const unsigned (&v)[32], unsigned cand) {
    int tot = 0;
#pragma unroll
    for (int i = 0; i < NR; ++i) tot += __builtin_popcountll(__ballot(v[i] >= cand));
    return tot;
}
template <int NR> DI unsigned sel_threshold(const unsigned (&v)[32]) {
    unsigned kmax = v[0];
#pragma unroll
    for (int i = 1; i < NR; ++i) kmax = v[i] > kmax ? v[i] : kmax;
#pragma unroll
    for (int o = 1; o < 64; o <<= 1) { const unsigned x = (unsigned)__shfl_xor((int)kmax, o); kmax = x > kmax ? x : kmax; }
    unsigned T = 0u; int bit0 = 31; bool done = false;
    {
        unsigned P = kmax & 0xFF800000u;
        for (int d = 0; d < 8 && P >= 0x80800000u; ++d, P -= 0x00800000u) {
            const int cnt = wave_count_ge<NR>(v, P);
            if (cnt >= 256) { T = P; bit0 = 22; done = (cnt == 256); break; }
        }
    }
    if (!done)
        for (int bit = bit0; bit >= 0; --bit) {
            const unsigned cand = T | (1u << bit); const int cnt = wave_count_ge<NR>(v, cand);
            if (cnt >= 256) { T = cand; if (cnt == 256) break; }
        }
    return T;
}
DI void sel_row(const unsigned (&v)[32], GAS unsigned long long* bm, int t, int lane) {
    typedef unsigned long long u64;
    if (t < 256) { if (lane < 32) bm[lane] = ~0ull; return; }
    const int ntl = (t >> 6) + 1;
    const unsigned T = ntl <= 8 ? sel_threshold<8>(v) : ntl <= 16 ? sel_threshold<16>(v) : ntl <= 24 ? sel_threshold<24>(v) : sel_threshold<32>(v);
    u64 mine = 0ull;
#pragma unroll
    for (int i = 0; i < 32; ++i) { const u64 bal = __ballot(v[i] >= T); if (lane == i) mine = bal; }
    if (lane < 32) bm[lane] = mine;
}
DI void dsa_select_unit(Frame& F, int u) {
    const int lane = F.lane, wave = F.wave;
    {
    const int m0 = 32 * u + 4 * wave, t0 = m0 & (SEQ - 1);
    const GAS float* sc = (const GAS float*)(F.ws + A_SC) + (size_t)m0 * SEQ; GAS unsigned long long* bm = (GAS unsigned long long*)(F.ws + A_BM) + (size_t)m0 * 32;
    unsigned va[32], vb[32];
    if (t0 >= 256) { sel_load(va, sc, t0, lane); sel_load(vb, sc + SEQ, t0 + 1, lane); }
    sel_row(va, bm, t0, lane);
    if (t0 >= 256) sel_load(va, sc + 2 * SEQ, t0 + 2, lane);
    sel_row(vb, bm + 32, t0 + 1, lane);
    if (t0 >= 256) sel_load(vb, sc + 3 * SEQ, t0 + 3, lane);
    sel_row(va, bm + 64, t0 + 2, lane);
    sel_row(vb, bm + 96, t0 + 3, lane);
    }
}

DI void dsa_attn_unit(Frame& F, int b, int u) {
    using namespace at;
    LAS unsigned char* lds = F.lds; const int tid = F.tid, lane = F.lane, wave = F.wave;
    const int t = 8 * u + wave, qblk = t / 6, hd = t - 6 * qblk, q = 32 * qblk + (lane & 31); const size_t qrow = (size_t)b * SEQ + q;
    bf16x8 qf[8]; load_q(qf, (const GAS bf16*)(F.ws + A_DQ) + qrow * 768 + hd * 128, lane);
    f32x16 O[4];
#pragma unroll
    for (int d = 0; d < 4; ++d)
#pragma unroll
        for (int r = 0; r < 16; ++r) O[d][r] = 0.f;
    float m = 0.f, l = 0.f;
    const int lastq = 32 * ((8 * u + 7) / 6) + 31;
    const GAS bf16* Kg = (const GAS bf16*)(F.ws + A_KD) + (size_t)b * SEQ * 128; const GAS bf16* Vg = (const GAS bf16*)(F.ws + A_VD) + (size_t)b * SEQ * 128;
    attn_pass<false, true>(lds, Kg, 128, Vg, 128, SEQ - 1, tile_range(0, (lastq >> 6) + 1), qf, O, m, l, AllowDsa{q, (const GAS u64*)(F.ws + A_BM) + qrow * 32}, (LAS const float*)nullptr, tid, lane);
    const float lt = l + __shfl_xor(l, 32);
    store_o((GAS bf16*)(F.ws + A_OD) + qrow * 768 + hd * 128, O, lt > 0.f ? 1.0f / lt : 0.f, lane);
}

DI void nsa_unit(Frame& F, int b, int qb) {
    using namespace at;
    LAS unsigned char* lds = F.lds; const int tid = F.tid, lane = F.lane, wave = F.wave, r32 = lane & 31, h = lane >> 5;
    LAS float* imp = (LAS float*)(lds + OFF_K2);
    LAS unsigned* selm = (LAS unsigned*)(lds + OFF_K2 + 8 * 32 * 33 * 4);
    const int hd = wave & 3, qs = wave >> 2, ql = 32 * qs + r32, q = 64 * qb + ql; const size_t qrow = (size_t)b * SEQ + q;
    for (int i = tid; i < 8 * 32 * 33 + 65; i += 512) imp[i] = 0.f;
    bf16x8 qf[8]; load_q(qf, (const GAS bf16*)(F.ws + A_NQ) + qrow * 512 + hd * 128, lane);
    const GAS float* gl = (const GAS float*)(F.ws + A_SM) + qrow * 64 + 6 + 3 * hd;
    const float g0 = sigm(gl[0]), g1 = sigm(gl[1]), g2 = sigm(gl[2]);
    GAS float* ocs = (GAS float*)(F.ws + A_OCS) + qrow * 512 + hd * 128 + 4 * h;
    {
        KVRegs R; const GAS bf16* Kg = (const GAS bf16*)(F.ws + A_KCMP) + (size_t)b * 128 * 128; const GAS bf16* Vg = (const GAS bf16*)(F.ws + A_VCMP) + (size_t)b * 128 * 128;
        kv_load(R, Kg, 128, Vg, 128, 0, 127, tid); kv_store(lds, OFF_K0, OFF_V0, R, tid);
        kv_load(R, Kg, 128, Vg, 128, 64, 127, tid); kv_store(lds, OFF_K1, OFF_V1, R, tid);
        __syncthreads();
        f32x16 s0, s1, s2, s3;
        qk_tile<false>(s0, s1, lds + OFF_K0, qf, (LAS const float*)nullptr, lane);
        qk_tile<false>(s2, s3, lds + OFF_K1, qf, (LAS const float*)nullptr, lane);
        const int cmax = (q - 31) >> 4;
        mask_tile(s0, s1, range_mask(0, cmax), h); mask_tile(s2, s3, range_mask(0, cmax - 64), h);
        float mx = -1e25f;
#pragma unroll
        for (int r = 0; r < 16; ++r) mx = fmaxf(mx, fmaxf(fmaxf(s0[r], s1[r]), fmaxf(s2[r], s3[r])));
        mx = fmaxf(mx, __shfl_xor(mx, 32));
        float sum = 0.f;
#pragma unroll
        for (int r = 0; r < 16; ++r) { s0[r] = ex2(s0[r] - mx); s1[r] = ex2(s1[r] - mx); s2[r] = ex2(s2[r] - mx); s3[r] = ex2(s3[r] - mx); sum += (s0[r] + s1[r]) + (s2[r] + s3[r]); }
        sum += __shfl_xor(sum, 32);
        const float inv = sum > 0.f ? 1.0f / sum : 0.f;
#pragma unroll
        for (int r = 0; r < 16; ++r) { s0[r] *= inv; s1[r] *= inv; s2[r] *= inv; s3[r] *= inv; }
#pragma unroll
        for (int g = 0; g < 4; ++g) {
            LAS float* ip = imp + (wave * 32 + r32) * 33 + 2 * g + h;
            LADD(ip, s0[4 * g] + s0[4 * g + 1] + s0[4 * g + 2] + 0.5f * s0[4 * g + 3]); LADD(ip + 1, 0.5f * s0[4 * g + 3]);
            LADD(ip + 8, s1[4 * g] + s1[4 * g + 1] + s1[4 * g + 2] + 0.5f * s1[4 * g + 3]); LADD(ip + 9, 0.5f * s1[4 * g + 3]);
            LADD(ip + 16, s2[4 * g] + s2[4 * g + 1] + s2[4 * g + 2] + 0.5f * s2[4 * g + 3]); LADD(ip + 17, 0.5f * s2[4 * g + 3]);
            LADD(ip + 24, s3[4 * g] + s3[4 * g + 1] + s3[4 * g + 2] + 0.5f * s3[4 * g + 3]); if (2 * g + h + 25 < 33) LADD(ip + 25, 0.5f * s3[4 * g + 3]);
        }
        f32x16 O[4];
#pragma unroll
        for (int d = 0; d < 4; ++d)
#pragma unroll
            for (int r = 0; r < 16; ++r) O[d][r] = 0.f;
        pv_tile(O, lds + OFF_V0, s0, s1, lane); pv_tile(O, lds + OFF_V1, s2, s3, lane);
#pragma unroll
        for (int d = 0; d < 4; ++d)
#pragma unroll
            for (int g = 0; g < 4; ++g) *(f32x4*)(ocs + 32 * d + 8 * g) = (f32x4){g0 * O[d][4 * g], g0 * O[d][4 * g + 1], g0 * O[d][4 * g + 2], g0 * O[d][4 * g + 3]};
    }
    __syncthreads();
    {
        const int qq = tid >> 3, sub = tid & 7, qpos = 64 * qb + qq, cur = qpos >> 6;
        float val[32];
#pragma unroll
        for (int j = 0; j < 32; ++j) { const bool forced = (j == 0) | (j == cur) | (j == cur - 1); const LAS float* ib = imp + ((qq >> 5) * 4 * 32 + (qq & 31)) * 33 + j; const float iv = ((ib[0] + ib[32 * 33]) + ib[2 * 32 * 33]) + ib[3 * 32 * 33];
            val[j] = forced ? 1e4f : (j <= cur ? iv : -1e4f); }
        unsigned bits = 0u;
#pragma unroll
        for (int jj = 0; jj < 4; ++jj) {
            int rank = 0; float mine = 0.f; const int j = 4 * sub + jj;
#pragma unroll
            for (int i = 0; i < 32; ++i) mine = (i == j) ? val[i] : mine;
#pragma unroll
            for (int i = 0; i < 32; ++i) rank += (val[i] > mine || (val[i] == mine && i < j)) ? 1 : 0;
            if (rank < 16) bits |= 1u << j;
        }
        bits |= __shfl_xor(bits, 1); bits |= __shfl_xor(bits, 2); bits |= __shfl_xor(bits, 4);
        __syncthreads();
        if (sub == 0) { selm[qq] = bits; __hip_atomic_fetch_or(&selm[64], bits, __ATOMIC_RELAXED, __HIP_MEMORY_SCOPE_WORKGROUP); }
    }
    __syncthreads();
    const unsigned sel = selm[ql], tset_slc = selm[64] & tile_range(0, qb + 1);
    {
        f32x16 O[4];
#pragma unroll
        for (int d = 0; d < 4; ++d)
#pragma unroll
            for (int r = 0; r < 16; ++r) O[d][r] = 0.f;
        float m = 0.f, l = 0.f;
        const GAS bf16* Kg = (const GAS bf16*)(F.ws + A_KS) + (size_t)b * SEQ * 128; const GAS bf16* Vg = (const GAS bf16*)(F.ws + A_VS) + (size_t)b * SEQ * 128;
        attn_pass<false, false>(lds, Kg, 128, Vg, 128, SEQ - 1, tset_slc, qf, O, m, l, AllowSlc{q, sel}, (LAS const float*)nullptr, tid, lane);
        const float lt = l + __shfl_xor(l, 32), sc = lt > 0.f ? g1 / lt : 0.f;
#pragma unroll
        for (int d = 0; d < 4; ++d)
#pragma unroll
            for (int g = 0; g < 4; ++g) { f32x4 t = *(const f32x4*)(ocs + 32 * d + 8 * g); t[0] += sc * O[d][4 * g]; t[1] += sc * O[d][4 * g + 1]; t[2] += sc * O[d][4 * g + 2]; t[3] += sc * O[d][4 * g + 3]; *(f32x4*)(ocs + 32 * d + 8 * g) = t; }
    }
    {
        f32x16 O[4];
#pragma unroll
        for (int d = 0; d < 4; ++d)
#pragma unroll
            for (int r = 0; r < 16; ++r) O[d][r] = 0.f;
        float m = 0.f, l = 0.f;
        const GAS bf16* Kg = (const GAS bf16*)(F.ws + A_KW) + (size_t)b * SEQ * 128; const GAS bf16* Vg = (const GAS bf16*)(F.ws + A_VW) + (size_t)b * SEQ * 128;
        const int j0 = qb - 8 < 0 ? 0 : qb - 8;
        attn_pass<false, false>(lds, Kg, 128, Vg, 128, SEQ - 1, tile_range(j0, qb + 1), qf, O, m, l, AllowWin{q}, (LAS const float*)nullptr, tid, lane);
        const float lt = l + __shfl_xor(l, 32), sc = lt > 0.f ? g2 / lt : 0.f;
        GAS bf16* orow = (GAS bf16*)(F.ws + A_ON) + qrow * 768 + hd * 128 + 4 * h;
#pragma unroll
        for (int d = 0; d < 4; ++d)
#pragma unroll
            for (int g = 0; g < 4; ++g) { const f32x4 t = *(const f32x4*)(ocs + 32 * d + 8 * g);
                *(v2u*)(orow + 32 * d + 8 * g) = (v2u){cvtpk(t[0] + sc * O[d][4 * g], t[1] + sc * O[d][4 * g + 1]), cvtpk(t[2] + sc * O[d][4 * g + 2], t[3] + sc * O[d][4 * g + 3])}; }
    }
}
DI GAS unsigned char* launder(GAS unsigned char* p) { asm volatile("" : "+s"(p)); return p; }
DI int launder_i(int v) { asm volatile("" : "+s"(v)); return v; }
#ifndef UDUP
#define UDUP 0
#endif
#ifndef DUPM
#define DUPM 0
#endif
#ifndef SKIPU
#define SKIPU 0
#endif
#ifndef SKIPM
#define SKIPM 0
#endif
#define GRID_BAR() do { XcdBarrier b2_ = bar; b2_.bar = (unsigned*)launder((GAS unsigned char*)bar.bar); b2_.x = (unsigned)launder_i((int)bar.x); xcd_barrier(b2_); } while (0)
#define PHASE_BEGIN() ws = launder(ws0); F.ws = ws; { int w_ = wave0; asm volatile("" : "+s"(w_)); int l_ = (int)__builtin_amdgcn_mbcnt_hi(~0u, __builtin_amdgcn_mbcnt_lo(~0u, 0u)); asm volatile("" : "+v"(l_)); F.wave = w_; F.lane = l_; F.tid = w_ * 64 + l_; } F.ctl = (gu32*)(ws + WS_CTL); const GAS unsigned char* wl = ws + WS_W + (size_t)l * W_LAYER; (void)wl; \
    GAS bf16* const xb_in = (GAS bf16*)(ws + ((l & 1) ? A_XB1 : A_XB0)); GAS bf16* const xb_out = (GAS bf16*)(ws + ((l & 1) ? A_XB0 : A_XB1)); (void)xb_in; (void)xb_out; GAS _Float16* const VA = (GAS _Float16*)(ws + A_VA); (void)VA;
DI void touch(const Frame& F, const GAS unsigned char* p, unsigned bytes) {
    const unsigned dump = (unsigned)__builtin_amdgcn_readfirstlane((int)((unsigned)(size_t)F.lds + 131072u));
    const unsigned np = bytes >> 10;
    for (unsigned i = (unsigned)(F.vcu * NWAVES + F.wave); i < np; i += (unsigned)(F.G * NWAVES)) at::glds16(p + ((size_t)i << 10) + F.lane * 16, dump);
}
#ifndef TOUCH
#define TOUCH 1
#endif
__global__ void __launch_bounds__(NWAVES * 64, 2) fwd(Args args) {
    extern __shared__ __attribute__((aligned(16))) unsigned char lds[];
    Frame F;
    F.lds = (LAS unsigned char*)lds;
    F.MISC = (volatile LAS unsigned*)(F.lds + MISC_OFF);
    F.tid = threadIdx.x; F.lane = F.tid & 63; F.wave = __builtin_amdgcn_readfirstlane(F.tid >> 6); const int wave0 = F.wave;
    F.G = gridDim.x; { const int bx = blockIdx.x; F.vcu = (F.G % 8 == 0) ? (bx % 8) * (F.G / 8) + bx / 8 : bx; }
    GAS unsigned char* const ws0 = (GAS unsigned char*)args.ws; GAS unsigned char* ws = ws0; F.ws = ws;
    F.ctl = (gu32*)(ws + WS_CTL);
    for (int u = F.tid; u < (LDS_BYTES - LDSCTL_OFF) / 4; u += NWAVES * 64) ((LAS unsigned*)(F.lds + LDSCTL_OFF))[u] = 0u;
    __syncthreads();
    XcdBarrier bar = xcd_barrier_post((unsigned*)(F.ctl + CW_BAR), F.MISC + 8);
    const int cid = (int)blockIdx.x;

    if (!(SKIPM & 1)) p0_prologue(F, args);
    GRID_BAR();
    if (DUPM & 1) { p0_prologue(F, args); GRID_BAR(); }
    if (TOUCH) touch(F, ws + WS_W + WO_IN, 4096u * 4096u + 7936u * 2048u);
    p0_cvec(F, args, 0);

    for (int l = 0; l < NL; ++l) {
        for (int rep_ = 0, nrep_ = launder_i(((DUPM >> 1) & 1) + 1); rep_ < nrep_; ++rep_) {
        if (!(SKIPM & (1 << 1))) {
            PHASE_BEGIN();
            {
                pg8::Gemm g{(const bf16*)(ws + A_X8B), (const bf16*)(wl + WO_ING8), MTOK, 7936, launder_i(1024), launder_i(0x7f7f7f7f), launder_i(0x7a7a7a7a)}; pg8::PanelOrder S; S.init(MTOK, 7936, F.G, cid);
                pg8::EpiInProj E{(GAS bf16*)(ws + A_FQ), (GAS bf16*)(ws + A_FK), (GAS bf16*)(ws + A_FV), (GAS bf16*)(ws + A_NQ), (GAS bf16*)(ws + A_KC), (GAS bf16*)(ws + A_VC), (GAS bf16*)(ws + A_KS), (GAS bf16*)(ws + A_VS),
                                 (GAS bf16*)(ws + A_KW), (GAS bf16*)(ws + A_VW), (GAS bf16*)(ws + A_DQ), (GAS bf16*)(ws + A_CKV), (GAS bf16*)(ws + A_IQ), (GAS bf16*)(ws + A_IK), ws + A_G, (GAS float*)(ws + A_SM),
                                 (const GAS pg8::f32x2e*)(ws + WS_ROPE128), (const GAS pg8::f32x2e*)(ws + WS_ROPE64), 1};
                pg8::gemm_phase<pg8::EpiInProj, pg8::PanelOrder, true, true, true>(F.lds + RING_OFF, g, S, E, wave0);
            }
            {
                pg8::Gemm g{(const bf16*)xb_in, (const bf16*)(wl + WO_IN), MTOK, 4096, launder_i(2048)}; pg8::PanelOrder S; S.init(MTOK, 4096, F.G, cid);
                pg8::EpiInProj E{(GAS bf16*)(ws + A_FQ), (GAS bf16*)(ws + A_FK), (GAS bf16*)(ws + A_FV), (GAS bf16*)(ws + A_NQ), (GAS bf16*)(ws + A_KC), (GAS bf16*)(ws + A_VC), (GAS bf16*)(ws + A_KS), (GAS bf16*)(ws + A_VS),
                                 (GAS bf16*)(ws + A_KW), (GAS bf16*)(ws + A_VW), (GAS bf16*)(ws + A_DQ), (GAS bf16*)(ws + A_CKV), (GAS bf16*)(ws + A_IQ), (GAS bf16*)(ws + A_IK), ws + A_G, (GAS float*)(ws + A_SM),
                                 (const GAS pg8::f32x2e*)(ws + WS_ROPE128), (const GAS pg8::f32x2e*)(ws + WS_ROPE64), 0};
                pg8::gemm_phase<pg8::EpiInProj, pg8::PanelOrder, true, true>(F.lds + RING_OFF, g, S, E, wave0);
            }

        }
        if (rep_ + 1 < nrep_) GRID_BAR();
        }
        GRID_BAR();
        for (int rep_ = 0, nrep_ = launder_i(((DUPM >> 4) & 1) + 1); rep_ < nrep_; ++rep_) {
        if (!(SKIPM & (1 << 4))) {
            PHASE_BEGIN();
            gu32* head = F.ctl + CW_Q + 64 * (l * 4 + 2 + 16 * rep_);
            gu32* flg = F.ctl + CW_FLAG + 320 * l;
            gu32* chead = F.ctl + CW_Q + 64 * (l * 4 + 1 + 16 * rep_); const bool conv = launder_i(l + 1) < NL;
            for (;;) {
                const int idx = q_next(F, head);
                { int l_ = F.lane; asm volatile("" : "+v"(l_)); F.lane = l_; F.tid = F.wave * 64 + l_; }
                if (idx >= 1056) { if (conv) while (conv_try(F, args, l + 1, chead)) {} break; }
                if (idx < 64) { compress1_unit(F, wl, l, idx); if ((UDUP >> 4) & 1) { __syncthreads(); compress1_unit(F, wl, l, idx); } unit_done(F, flg + 257); }
                else if (idx < 208) { const int i = idx - 64, b = i / 36; int r = i % 36, qb = 0; while (r > qb) { r -= qb + 1; ++qb; } indexer_unit(F, b, qb, r); if ((UDUP >> 0) & 1) { __syncthreads(); indexer_unit(F, b, qb, r); } unit_done(F, flg + 260 + 8 * b + qb); }
                else if (idx < 272) { kvup_unit(F, (const GAS bf16*)(wl + WO_KVUP), idx - 208); if ((UDUP >> 5) & 1) { __syncthreads(); kvup_unit(F, (const GAS bf16*)(wl + WO_KVUP), idx - 208); } unit_done(F, flg + 258); }
                else if (idx < 288) { unit_wait(F, flg + 257, flg + 257, 64u); compress2_unit(F, wl, idx - 272); unit_done(F, flg + 256); }
                else if (idx < 416) { const int nk = idx - 288;
                    if (conv) while (!unit_poll(F, flg + 256, 16u)) { if (!conv_try(F, args, l + 1, chead)) break; }
                    unit_wait(F, flg + 256, flg + 256, 16u); nsa_unit(F, nk & 3, 31 - (nk >> 2)); }
                else if (idx < 672) { const int i = idx - 416, b = i & 3, tb = 63 - (i >> 2), s = b * 64 + tb; if (conv) while (!unit_poll(F, flg + 260 + 8 * b + (tb >> 3), (unsigned)(tb >> 3) + 1u)) { if (!conv_try(F, args, l + 1, chead)) break; }
                    unit_wait(F, flg + 260 + 8 * b + (tb >> 3), flg + 260 + 8 * b + (tb >> 3), (unsigned)(tb >> 3) + 1u); dsa_select_unit(F, s); if ((UDUP >> 1) & 1) { __syncthreads(); dsa_select_unit(F, s); } unit_done(F, flg + s); }
                else if (idx < 768) { const int fk = idx - 672, qb = 7 - fk / 24, bh = fk % 24; fox_unit(F, (const GAS float*)args.in[3] + l * 6, bh / 6, bh % 6, qb);
                } else if (idx < 960) {
                    const int dk = idx - 768, b = dk & 3, u = 47 - (dk >> 2);
                    unit_wait(F, flg + 258, flg + 258, 64u);
                    unit_wait(F, flg + b * 64 + (8 * u) / 6, flg + b * 64 + (8 * u + 7) / 6, 1u);
                    dsa_attn_unit(F, b, u); if ((UDUP >> 2) & 1) { __syncthreads(); dsa_attn_unit(F, b, u); }
                } else { const int fk = idx - 960, qb = 3 - fk / 24, bh = fk % 24; fox_unit(F, (const GAS float*)args.in[3] + l * 6, bh / 6, bh % 6, qb); if ((UDUP >> 6) & 1) { __syncthreads(); fox_unit(F, (const GAS float*)args.in[3] + l * 6, bh / 6, bh % 6, qb); } }
            }
        }
        if (rep_ + 1 < nrep_) GRID_BAR();
        }
        GRID_BAR();
        for (int rep_ = 0, nrep_ = launder_i(((DUPM >> 5) & 1) + 1); rep_ < nrep_; ++rep_) {
        if (!(SKIPM & (1 << 5))) {
            PHASE_BEGIN();
            if (l + 1 < NL) p0_cvec(F, args, l + 1);
            if (TOUCH > 1) touch(F, wl + WO_OUT, 2048u * 2048u * 2u);
            pg8::SegOrder4 S; S.base.init(MTOK, DM, F.G, cid);
            pg8::SegGemm g{{(const bf16*)(ws + A_OF), (const bf16*)(ws + A_ON), (const bf16*)(ws + A_OD), (const bf16*)(ws + A_PB) + (size_t)l * MTOK * 768},
                           {(const bf16*)(wl + WO_BRF), (const bf16*)(wl + WO_BRN), (const bf16*)(wl + WO_BRD), (const bf16*)(wl + WO_PI)}, {12, 8, 12, 4}, launder_i(768)};
            pg8::EpiBranchSeg E{ws + A_G, (GAS bf16*)(ws + A_MIXB), (GAS bf16*)(ws + A_PLB)};
            pg8::gemm_phase<pg8::EpiBranchSeg, pg8::SegOrder4, true, true, false, pg8::SegGemm>(F.lds + RING_OFF, g, S, E, wave0);
        }
        if (rep_ + 1 < nrep_) GRID_BAR();
        }
        GRID_BAR();
        if (!(SKIPM & (1 << 6))) {
            PHASE_BEGIN();
            if (TOUCH > 1) touch(F, wl + WO_FFI, 11264u * 2048u);
            pg8::Gemm g{(const bf16*)(ws + A_MIXB), (const bf16*)(wl + WO_OUT), MTOK, DM, launder_i(2048)}; pg8::StaticOrder S; S.init(MTOK, DM, F.G, cid);
            pg8::EpiResidStats<false, true> E{VA, VA, ALPHA_F, nullptr, nullptr, nullptr, (const GAS float*)args.in[16] + (size_t)l * DM, ws + A_X8, (GAS pg8::f32x2e*)(ws + A_ST1), F.lds, F.tid};
            pg8::gemm_phase<pg8::EpiResidStats<false, true>, pg8::StaticOrder, true, true>(F.lds + RING_OFF, g, S, E, wave0);
        }
        GRID_BAR();
        for (int rep_ = 0, nrep_ = launder_i(((DUPM >> 8) & 1) + 1); rep_ < nrep_; ++rep_) {
        if (!(SKIPM & (1 << 8))) {
            PHASE_BEGIN();
            if (TOUCH > 1) touch(F, wl + WO_FFO, 2048u * 5632u);
            pg8::Gemm g{(const bf16*)(ws + A_X8), (const bf16*)(wl + WO_FFI), MTOK, 2 * DFF, launder_i(1024), launder_i(0x7f7f7f7f), launder_i(0x79797979)}; pg8::PanelOrder S; S.init(MTOK, 2 * DFF, F.G, cid);
            pg8::EpiSwiGLU E{ws + A_HID, (const GAS pg8::f32x2e*)(ws + A_ST1), (const GAS float*)(ws + A_CV) + (size_t)l * CV_LAYER, (const GAS float*)(ws + A_CV) + (size_t)l * CV_LAYER + 11264, F.lds, F.tid};
            pg8::gemm_phase<pg8::EpiSwiGLU, pg8::PanelOrder, true, true, true>(F.lds + RING_OFF, g, S, E, wave0);
        }
        if (rep_ + 1 < nrep_) GRID_BAR();
        }
        GRID_BAR();
        if (!(SKIPM & (1 << 9))) {
            PHASE_BEGIN();
            if (TOUCH > 1) touch(F, wl + WO_PG, 2048u * 2048u * 2u);
            pg8::Gemm g{(const bf16*)(ws + A_HID), (const bf16*)(wl + WO_FFO), MTOK, DM, launder_i(DFF / 2), launder_i(0x7b7b7b7b), launder_i(0x78787878)}; pg8::StaticOrder S; S.init(MTOK, DM, F.G, cid);
            pg8::EpiResidStats<true, false> E{VA, VA, ALPHA_F, (const GAS pg8::f32x2e*)(ws + A_ST1), (const GAS float*)args.in[16] + (size_t)l * DM, (const GAS float*)args.in[17] + (size_t)l * DM,
                                              (const GAS float*)args.in[20] + (size_t)l * DM, (GAS unsigned char*)xb_in, (GAS pg8::f32x2e*)(ws + A_ST2), F.lds, F.tid};
            pg8::gemm_phase<pg8::EpiResidStats<true, false>, pg8::StaticOrder, true, true, true>(F.lds + RING_OFF, g, S, E, wave0);
        }
        GRID_BAR();
        if (!(SKIPM & (1 << 11))) {
            PHASE_BEGIN();
            if (TOUCH && l + 1 < NL) { touch(F, wl + W_LAYER + WO_IN, 4096u * 4096u); touch(F, wl + W_LAYER + WO_ING8, 7936u * 2048u); }
            pg8::Gemm g{(const bf16*)xb_in, (const bf16*)(wl + WO_PG), MTOK, DM, launder_i(2048)}; pg8::StaticOrder S; S.init(MTOK, DM, F.G, cid);
            pg8::EpiPleGate E{VA, (const GAS bf16*)(ws + A_PLB), VA, l == NL - 1 ? (GAS float*)args.out : (GAS float*)nullptr, xb_out, ws + A_X8B, (const GAS pg8::f32x2e*)(ws + A_ST2), (const GAS float*)args.in[20] + (size_t)l * DM, (const GAS float*)args.in[21] + (size_t)l * DM,
                                 (const GAS float*)(ws + A_CV) + (size_t)l * CV_LAYER + 22528, (const GAS float*)(ws + A_CV) + (size_t)l * CV_LAYER + 22528 + 2048, F.lds, F.tid};
            pg8::gemm_phase<pg8::EpiPleGate, pg8::StaticOrder, true, true>(F.lds + RING_OFF, g, S, E, wave0);
        }
        if (l + 1 < NL) GRID_BAR();
    }
}

extern "C" void kernel_launch(void* const* d_in, const int* in_sizes, int n_in, void* d_out, int out_size, void* d_ws, size_t ws_size, hipStream_t stream) {
    static int grid = 0;
    if (grid == 0) {
        if (n_in != 24 || out_size != MTOK * DM || ws_size < WS_END) { fprintf(stderr, "kernel_launch: unexpected shapes (n_in %d, out %d, ws %zu < %zu)\n", n_in, out_size, ws_size, (size_t)WS_END); grid = -1; return; }
        int dev = 0, cus = 0, per_cu = 0;
        if (hipGetDevice(&dev) != hipSuccess || hipDeviceGetAttribute(&cus, hipDeviceAttributeMultiprocessorCount, dev) != hipSuccess) { grid = -1; return; }
        if (hipFuncSetAttribute((const void*)fwd, hipFuncAttributeMaxDynamicSharedMemorySize, LDS_BYTES) != hipSuccess) { fprintf(stderr, "kernel_launch: hipFuncSetAttribute failed\n"); grid = -1; return; }
        if (hipOccupancyMaxActiveBlocksPerMultiprocessor(&per_cu, (const void*)fwd, NWAVES * 64, LDS_BYTES) != hipSuccess || per_cu < 1) fprintf(stderr, "kernel_launch: occupancy query reports %d\n", per_cu);
        (void)hipGetLastError();
        grid = cus;
    }
    if (grid < 0) return;
    if (hipMemsetAsync((char*)d_ws + WS_CTL, 0, CTL_ZERO_BYTES, stream) != hipSuccess) return;
    Args a{};
    for (int i = 0; i < 24; ++i) a.in[i] = (const float*)d_in[i];
    a.out = (float*)d_out; a.ws = (unsigned char*)d_ws; a.pad0 = 0; a.pad1 = 0;
    hipLaunchKernelGGL(fwd, dim3(grid), dim3(NWAVES * 64), LDS_BYTES, stream, a);
}
```

```cpp
#include <hip/hip_runtime.h>
#include <hip/hip_bf16.h>
#include <cstdio>
#include <cstdint>

#define TOUCH 0
namespace pg8 {
#define PG8_LAS __attribute__((address_space(3)))
typedef unsigned short bf16_t;
typedef short bf16x8 __attribute__((ext_vector_type(8)));
typedef float f32x4 __attribute__((ext_vector_type(4)));
typedef unsigned u32x4 __attribute__((ext_vector_type(4)));
constexpr int BM = 256, BK = 64, HALF = 128, HTB = HALF * BK * 2  , STAGE_BYTES = 8 * HTB, NXCD = 8, WGM = 8;

__host__ __device__ __forceinline__ int lds_byte(int r, int c) { const int st = (r >> 4) * 2 + (c >> 5), rr = r & 15, cc = c & 31, ob = rr * 64 + cc * 2; return st * 1024 + (ob ^ (((ob >> 9) & 1) << 5)); }
__host__ __device__ __forceinline__ void stage_rc(int b, int& R, int& C) { const int st = b / 1024, sb = b % 1024, swz = sb ^ (((sb >> 9) & 1) << 5); R = (st >> 1) * 16 + swz / 64; C = (st & 1) * 32 + (swz % 64) / 2; }
__host__ __device__ __forceinline__ int perm32(int rho) { const int n = rho >> 4, i = rho & 15; return 8 * (i >> 2) + 4 * n + (i & 3); }

struct Unit { int pm, pn; int seg = 0; };
typedef int v4i_t __attribute__((ext_vector_type(4)));
typedef int v8i_t __attribute__((ext_vector_type(8)));
struct Gemm { const bf16_t* A; const bf16_t* Bt; int M, N, K; int sA = 0x7f7f7f7f, sB = 0x7f7f7f7f; };
struct SegGemm { const bf16_t* A[4]; const bf16_t* Bt[4]; int nt[4]; int ld; int sA = 0x7f7f7f7f, sB = 0x7f7f7f7f; };
__device__ __forceinline__ int gm_ld(const Gemm& g) { return g.K; }
__device__ __forceinline__ int gm_ld(const SegGemm& g) { return g.ld; }
__device__ __forceinline__ int gm_nt(const Gemm& g, int) { return g.K / 64; }
__device__ __forceinline__ int gm_nt(const SegGemm& g, int s) { return s == 0 ? g.nt[0] : s == 1 ? g.nt[1] : s == 2 ? g.nt[2] : g.nt[3]; }
__device__ __forceinline__ const char* gm_a(const Gemm& g, int) { return (const char*)g.A; }
__device__ __forceinline__ const char* gm_a(const SegGemm& g, int s) { return (const char*)(s == 0 ? g.A[0] : s == 1 ? g.A[1] : s == 2 ? g.A[2] : g.A[3]); }
__device__ __forceinline__ const char* gm_b(const Gemm& g, int) { return (const char*)g.Bt; }
__device__ __forceinline__ const char* gm_b(const SegGemm& g, int s) { return (const char*)(s == 0 ? g.Bt[0] : s == 1 ? g.Bt[1] : s == 2 ? g.Bt[2] : g.Bt[3]); }

struct StaticOrder {
    int nM, nN, nwg, G, c;
    __host__ __device__ void init(int M, int N, int G_, int c_) { nM = M / BM; nN = N / BM; nwg = nM * nN; G = G_; c = c_; }
    __host__ __device__ bool next(int i, Unit& u) const {
        const long L = (long)i * G + c; if (L >= nwg) return false;
        int wgid = (int)L; { const int q = nwg / NXCD, r = nwg % NXCD, xcd = wgid % NXCD, off = wgid / NXCD; wgid = (xcd < r ? xcd * (q + 1) : r * (q + 1) + (xcd - r) * q) + off; }
        const int nig = WGM * nN, gid = wgid / nig, fm = gid * WGM, gsz = (nM - fm) < WGM ? (nM - fm) : WGM;
        u.pm = fm + ((wgid % nig) % gsz); u.pn = (wgid % nig) / gsz; return true;
    }
    __device__ __forceinline__ void a_ready(const Unit&) const {}
    __device__ __forceinline__ void done(const Unit&) const {}
};

typedef float f32x2cv __attribute__((ext_vector_type(2))); typedef __bf16 bf16x2cv __attribute__((ext_vector_type(2)));
__device__ __forceinline__ unsigned cvt_pk_bf16(float lo, float hi) { f32x2cv v = {lo, hi}; bf16x2cv b = __builtin_convertvector(v, bf16x2cv); return __builtin_bit_cast(unsigned, b); }
typedef float f32x2 __attribute__((ext_vector_type(2)));
typedef float f32x2e __attribute__((ext_vector_type(2)));
#define PG8_GAS __attribute__((address_space(1)))
__device__ __forceinline__ float fast_sigmoid(float x) { return __builtin_amdgcn_rcpf(1.0f + __builtin_amdgcn_exp2f(-1.4426950408889634f * x)); }
__device__ __forceinline__ u32x4 pack8(const f32x4 a, const f32x4 b) { u32x4 w; w.x = cvt_pk_bf16(a[0], a[1]); w.y = cvt_pk_bf16(a[2], a[3]); w.z = cvt_pk_bf16(b[0], b[1]); w.w = cvt_pk_bf16(b[2], b[3]); return w; }
__device__ __forceinline__ float bf_lo(unsigned w) { return __uint_as_float(w << 16); }
__device__ __forceinline__ float bf_hi(unsigned w) { return __uint_as_float(w & 0xffff0000u); }

#define QSCALE 0.12751743074602467f

struct EpiInProj {
    static constexpr bool PERM = true, AFTER_DRAIN = false;
    PG8_GAS bf16_t *FQ, *FK, *FV, *NQ, *KC, *VC, *KS, *VS, *KW, *VW, *DQ, *CKV, *IQ, *IK; PG8_GAS unsigned char* G8; PG8_GAS float* SM; const PG8_GAS f32x2e* rope128; const PG8_GAS f32x2e* rope64;
    int mode;
    __device__ __forceinline__ void operator()(const f32x4 (&acc)[2][2][4][2], const Unit& u, int wr, int wc, int fr, int fq) const {
        const int i_ = u.pn;
        const int pn = mode == 0 ? (i_ < 6 ? i_ : i_ < 8 ? i_ + 3 : i_ < 11 ? i_ + 6 : i_ + 7) : (i_ < 24 ? 23 + i_ : i_ < 27 ? i_ - 18 : i_ < 30 ? i_ - 16 : 17);
#pragma unroll
        for (int bj = 0; bj < 2; ++bj) {
            const int cw = 32 * wc + 8 * fq;
            int kind; PG8_GAS bf16_t* dst; int pitch, col;
            if (pn < 3)        { kind = 0x100; dst = FQ; pitch = 768; col = pn * 256 + 128 * bj + cw; }
            else if (pn < 6)   { kind = 0; dst = FK; pitch = 768; col = (pn - 3) * 256 + 128 * bj + cw; }
            else if (pn < 9)   { kind = 0; dst = FV; pitch = 768; col = (pn - 6) * 256 + 128 * bj + cw; }
            else if (pn < 11)  { kind = 0x101; dst = NQ; pitch = 512; col = (pn - 9) * 256 + 128 * bj + cw; }
            else if (pn == 11) { kind = 0; dst = bj ? VC : KC; pitch = 128; col = cw; }
            else if (pn == 12) { kind = bj ? 0 : 1; dst = bj ? VS : KS; pitch = 128; col = cw; }
            else if (pn == 13) { kind = bj ? 0 : 1; dst = bj ? VW : KW; pitch = 128; col = cw; }
            else if (pn < 17)  { kind = 0x101; dst = DQ; pitch = 768; col = (pn - 14) * 256 + 128 * bj + cw; }
            else if (pn == 17) { kind = 0; dst = CKV; pitch = 256; col = 128 * bj + cw; }
            else if (pn < 22)  { kind = 2; dst = IQ; pitch = 1024; col = (pn - 18) * 256 + 128 * bj + cw; }
            else if (pn == 22) { if (bj == 0) { if (cw < 64) { kind = 2; dst = IK; pitch = 64; col = cw; } else { kind = 4; dst = nullptr; pitch = 64; col = cw - 64; } } else { kind = 5; dst = nullptr; pitch = 0; col = 0; } }
            else               { kind = 3; dst = nullptr; pitch = 6144; col = (pn - 23) * 256 + 128 * bj + cw; }
            if (kind == 5) continue;
            const float sc = (kind & 0x100) ? QSCALE : 1.0f; const int k = kind & 0xff;
#pragma unroll
            for (int ai = 0; ai < 2; ++ai)
#pragma unroll
                for (int m = 0; m < 4; ++m) {
                    const int row = u.pm * BM + ai * HALF + wr * 64 + m * 16 + fr; const int pos = row & 2047;
                    f32x4 v0 = acc[ai][bj][m][0], v1 = acc[ai][bj][m][1];
                    if (k == 1 || k == 2) {
                        const PG8_GAS f32x2e* tb = (k == 1) ? rope128 + (size_t)pos * 64 + (cw >> 1) : rope64 + (size_t)pos * 32 + ((cw & 63) >> 1);
                        const f32x4 cs0 = *(const PG8_GAS f32x4*)tb, cs1 = *(const PG8_GAS f32x4*)(tb + 2);
                        f32x4 o0, o1;
                        o0[0] = v0[0] * cs0[0] - v0[1] * cs0[1]; o0[1] = v0[0] * cs0[1] + v0[1] * cs0[0];
                        o0[2] = v0[2] * cs0[2] - v0[3] * cs0[3]; o0[3] = v0[2] * cs0[3] + v0[3] * cs0[2];
                        o1[0] = v1[0] * cs1[0] - v1[1] * cs1[1]; o1[1] = v1[0] * cs1[1] + v1[1] * cs1[0];
                        o1[2] = v1[2] * cs1[2] - v1[3] * cs1[3]; o1[3] = v1[2] * cs1[3] + v1[3] * cs1[2];
                        v0 = o0; v1 = o1;
                    } else if (k == 3) {
                        typedef unsigned u32x2g __attribute__((ext_vector_type(2))); u32x2g w; unsigned x = 0u;
#pragma unroll
                        for (int e = 0; e < 4; ++e) x = __builtin_amdgcn_cvt_pk_u8_f32(255.0f * fast_sigmoid(v0[e]), e, x);
                        w.x = x; x = 0u;
#pragma unroll
                        for (int e = 0; e < 4; ++e) x = __builtin_amdgcn_cvt_pk_u8_f32(255.0f * fast_sigmoid(v1[e]), e, x);
                        w.y = x; *(PG8_GAS u32x2g*)(G8 + (size_t)row * 6144 + col) = w; continue;
                    }
                    if (k == 4) { PG8_GAS float* p = SM + (size_t)row * 64 + col; *(PG8_GAS f32x4*)p = v0; *(PG8_GAS f32x4*)(p + 4) = v1; }
                    else { v0 = v0 * sc; v1 = v1 * sc; *(PG8_GAS u32x4*)(dst + (size_t)row * pitch + col) = pack8(v0, v1); }
                }
        }
    }
};

struct EpiGate {
    static constexpr bool PERM = true, AFTER_DRAIN = false;
    PG8_GAS unsigned char* G;
    __device__ __forceinline__ void operator()(const f32x4 (&acc)[2][2][4][2], const Unit& u, int wr, int wc, int fr, int fq) const {
        typedef unsigned u32x2e __attribute__((ext_vector_type(2)));
#pragma unroll
        for (int ai = 0; ai < 2; ++ai)
#pragma unroll
            for (int m = 0; m < 4; ++m) {
                const int row = u.pm * BM + ai * HALF + wr * 64 + m * 16 + fr;
#pragma unroll
                for (int bj = 0; bj < 2; ++bj) { const f32x4 v0 = acc[ai][bj][m][0], v1 = acc[ai][bj][m][1]; u32x2e w; unsigned x = 0u;
#pragma unroll
                    for (int e = 0; e < 4; ++e) x = __builtin_amdgcn_cvt_pk_u8_f32(255.0f * fast_sigmoid(v0[e]), e, x);
                    w.x = x; x = 0u;
#pragma unroll
                    for (int e = 0; e < 4; ++e) x = __builtin_amdgcn_cvt_pk_u8_f32(255.0f * fast_sigmoid(v1[e]), e, x);
                    w.y = x;
                    *(PG8_GAS u32x2e*)(G + (size_t)row * 6144 + u.pn * BM + bj * HALF + wc * 32 + 8 * fq) = w; }
            }
    }
};

struct EpiBranchSeg {
    static constexpr bool PERM = true, AFTER_DRAIN = false, KEEP_ACC = true;
    static __device__ __forceinline__ bool keeps(const Unit& u) { return u.seg < 2; }
    const PG8_GAS unsigned char* G; PG8_GAS bf16_t* MIXB; PG8_GAS bf16_t* PLB;
    __device__ __forceinline__ void operator()(f32x4 (&acc)[2][2][4][2], const Unit& u, int wr, int wc, int fr, int fq) const {
        typedef unsigned u32x2e __attribute__((ext_vector_type(2)));
        const int seg = u.seg;
        const int col0 = u.pn * BM + wc * 32 + 8 * fq;
#pragma unroll
        for (int ai = 0; ai < 2; ++ai) {
            const int row0 = u.pm * BM + ai * HALF + wr * 64 + fr;
            if (seg == 3) {
#pragma unroll
                for (int m = 0; m < 4; ++m)
#pragma unroll
                    for (int bj = 0; bj < 2; ++bj) *(PG8_GAS u32x4*)(PLB + (size_t)(row0 + m * 16) * 2048 + col0 + bj * HALF) = pack8(acc[ai][bj][m][0], acc[ai][bj][m][1]);
            } else {
                u32x2e gn[4][2], gd[4][2];
#pragma unroll
                for (int m = 0; m < 4; ++m)
#pragma unroll
                    for (int bj = 0; bj < 2; ++bj) { const PG8_GAS unsigned char* gp = G + (size_t)(row0 + m * 16) * 6144 + seg * 2048 + col0 + bj * HALF;
                        gn[m][bj] = *(const PG8_GAS u32x2e*)gp; gd[m][bj] = seg < 2 ? *(const PG8_GAS u32x2e*)(gp + 2048) : (u32x2e){0x01010101u, 0x01010101u}; }
                asm volatile("" ::: "memory");
#pragma unroll
                for (int m = 0; m < 4; ++m)
#pragma unroll
                    for (int bj = 0; bj < 2; ++bj) {
                        f32x4 f[2];
#pragma unroll
                        for (int hh = 0; hh < 2; ++hh) { const unsigned a_ = hh ? gn[m][bj].y : gn[m][bj].x, d_ = hh ? gd[m][bj].y : gd[m][bj].x;
#pragma unroll
                            for (int e2 = 0; e2 < 4; ++e2) { float nu = (float)((a_ >> (8 * e2)) & 0xffu); if (seg > 0) nu = fmaxf(nu, 1.0f);
                                const float de = seg < 2 ? __builtin_amdgcn_rcpf(fmaxf((float)((d_ >> (8 * e2)) & 0xffu), 1.0f)) : (1.0f / 255.0f);
                                f[hh][e2] = nu * de; } }
                        acc[ai][bj][m][0] = acc[ai][bj][m][0] * f[0]; acc[ai][bj][m][1] = acc[ai][bj][m][1] * f[1];
                        if (seg == 2) *(PG8_GAS u32x4*)(MIXB + (size_t)(row0 + m * 16) * 2048 + col0 + bj * HALF) = pack8(acc[ai][bj][m][0], acc[ai][bj][m][1]);
                    }
            }
            asm volatile("" ::: "memory");
        }
    }
};
struct PanelOrder {
    int nM, nN, G, c;
    __device__ __forceinline__ void init(int M, int N, int G_, int c_) { nM = M / BM; nN = N / BM; G = G_; c = c_; }
    __device__ __forceinline__ bool next(int i, Unit& u) const { const int per = G / nM; if (per < 1 || c >= per * nM) return false; const int pn = c / nM + per * i; if (pn >= nN) return false; u.pm = c % nM; u.pn = pn; u.seg = i; return true; }
    __device__ __forceinline__ void a_ready(const Unit&) const {}
    __device__ __forceinline__ void done(const Unit&) const {}
};
struct SegOrder4 {
    StaticOrder base;
    __device__ __forceinline__ bool next(int i, Unit& u) const { const bool ok = base.next(i >> 2, u); u.seg = i & 3; return ok; }
    __device__ __forceinline__ void a_ready(const Unit&) const {}
    __device__ __forceinline__ void done(const Unit&) const {}
};

typedef _Float16 f16x8e __attribute__((ext_vector_type(8)));
typedef float f32x8e __attribute__((ext_vector_type(8)));
__device__ __forceinline__ void ld_h8(const PG8_GAS _Float16* p, f32x4& a, f32x4& b) { const f16x8e h = *(const PG8_GAS f16x8e*)p; const f32x8e f = __builtin_convertvector(h, f32x8e);
    a = (f32x4){f[0], f[1], f[2], f[3]}; b = (f32x4){f[4], f[5], f[6], f[7]}; }
__device__ __forceinline__ void st_h8(PG8_GAS _Float16* p, const f32x4& a, const f32x4& b) { const f32x8e f = {a[0], a[1], a[2], a[3], b[0], b[1], b[2], b[3]}; *(PG8_GAS f16x8e*)p = __builtin_convertvector(f, f16x8e); }
__device__ __forceinline__ void row_stats_table(const PG8_GAS f32x2e* ST, int pm, PG8_LAS f32x2e* tbl, int tid) {
    if (tid < 256) {
        const PG8_GAS f32x4* p = (const PG8_GAS f32x4*)(ST + (size_t)(pm * BM + tid) * 8);
        float s = 0.f, q = 0.f;
#pragma unroll
        for (int i = 0; i < 4; ++i) { const f32x4 w = p[i]; s += w[0]; q += w[1]; s += w[2]; q += w[3]; }
        const float mean = s * (1.0f / 2048.0f), var = q * (1.0f / 2048.0f) - mean * mean;
        tbl[tid] = (f32x2e){mean, 1.0f / __builtin_sqrtf(var + 1e-5f)};
    }
    asm volatile("s_waitcnt lgkmcnt(0)\n\ts_barrier" ::: "memory");
}
template <bool LNRES, bool OUT8> struct EpiResidStats {
    static constexpr bool PERM = true, AFTER_DRAIN = false;
    const PG8_GAS _Float16* res; PG8_GAS _Float16* out; float alpha;
    const PG8_GAS f32x2e* STin; const PG8_GAS float* gr; const PG8_GAS float* br;
    const PG8_GAS float* gn; PG8_GAS unsigned char* xo; PG8_GAS f32x2e* STout;
    PG8_LAS unsigned char* lds; int tid;
    static constexpr int RB = LNRES ? 1 : 2;
    __device__ __forceinline__ void operator()(const f32x4 (&acc)[2][2][4][2], const Unit& u, int wr, int wc, int fr, int fq) const {
        typedef unsigned u32x2e __attribute__((ext_vector_type(2)));
        PG8_LAS f32x2e* tbl = (PG8_LAS f32x2e*)(lds + 133120);
        if (LNRES) row_stats_table(STin, u.pm, tbl, tid);
        const int col0 = u.pn * BM + wc * 32 + 8 * fq;
        PG8_LAS f32x2e* part = (PG8_LAS f32x2e*)(lds + 133120 + 2048);
        f32x4 gnv[2][2], grv[2][2], brv[2][2];
#pragma unroll
        for (int bj = 0; bj < 2; ++bj)
#pragma unroll
            for (int n = 0; n < 2; ++n) { const int c = col0 + bj * HALF + 4 * n; gnv[bj][n] = *(const PG8_GAS f32x4*)(gn + c);
                if (LNRES) { grv[bj][n] = *(const PG8_GAS f32x4*)(gr + c); brv[bj][n] = *(const PG8_GAS f32x4*)(br + c); } }
#pragma unroll
        for (int ai = 0; ai < 2; ++ai)
#pragma unroll
            for (int mp = 0; mp < 4 / RB; ++mp) {
                const int rl0 = ai * HALF + wr * 64 + mp * (16 * RB) + fr;
                f32x4 r[RB][2][2];
#pragma unroll
                for (int mm = 0; mm < RB; ++mm)
#pragma unroll
                    for (int bj = 0; bj < 2; ++bj) { const size_t off = (size_t)(u.pm * BM + rl0 + mm * 16) * 2048 + col0 + bj * HALF; ld_h8(res + off, r[mm][bj][0], r[mm][bj][1]); }
                asm volatile("" ::: "memory");
#pragma unroll
                for (int mm = 0; mm < RB; ++mm) { const int m = RB * mp + mm; float s = 0.f, q = 0.f;
                    f32x2e st; if (LNRES) st = tbl[rl0 + mm * 16];
#pragma unroll
                    for (int bj = 0; bj < 2; ++bj) { const size_t off = (size_t)(u.pm * BM + rl0 + mm * 16) * 2048 + col0 + bj * HALF;
                        f32x4 r0 = r[mm][bj][0], r1 = r[mm][bj][1];
                        if (LNRES) { r0 = (r0 - st.x) * st.y * grv[bj][0] + brv[bj][0]; r1 = (r1 - st.x) * st.y * grv[bj][1] + brv[bj][1]; }
                        const f32x4 v0 = r0 * alpha + acc[ai][bj][m][0], v1 = r1 * alpha + acc[ai][bj][m][1];
                        st_h8(out + off, v0, v1);
                        s += ((v0[0] + v0[1]) + (v0[2] + v0[3])) + ((v1[0] + v1[1]) + (v1[2] + v1[3]));
                        q += ((v0[0] * v0[0] + v0[1] * v0[1]) + (v0[2] * v0[2] + v0[3] * v0[3])) + ((v1[0] * v1[0] + v1[1] * v1[1]) + (v1[2] * v1[2] + v1[3] * v1[3]));
                        const f32x4 a0 = v0 * gnv[bj][0], a1 = v1 * gnv[bj][1];
                        if (OUT8) { u32x2e w8; unsigned x = 0u; x = __builtin_amdgcn_cvt_pk_fp8_f32(a0[0], a0[1], x, false); x = __builtin_amdgcn_cvt_pk_fp8_f32(a0[2], a0[3], x, true); w8.x = x;
                            x = 0u; x = __builtin_amdgcn_cvt_pk_fp8_f32(a1[0], a1[1], x, false); x = __builtin_amdgcn_cvt_pk_fp8_f32(a1[2], a1[3], x, true); w8.y = x; *(PG8_GAS u32x2e*)(xo + off) = w8; }
                        else *(PG8_GAS u32x4*)((PG8_GAS bf16_t*)xo + off) = pack8(a0, a1); }
                    s += __shfl_xor(s, 16); q += __shfl_xor(q, 16); s += __shfl_xor(s, 32); q += __shfl_xor(q, 32);
                    if (fq == 0) part[(rl0 + mm * 16) * 4 + wc] = (f32x2e){s, q};
                }
                asm volatile("" ::: "memory");
            }
        asm volatile("s_waitcnt lgkmcnt(0)\n\ts_barrier" ::: "memory");
        if (tid < 256) { const f32x2e p0 = part[tid * 4], p1 = part[tid * 4 + 1], p2 = part[tid * 4 + 2], p3 = part[tid * 4 + 3];
            STout[(size_t)(u.pm * BM + tid) * 8 + u.pn] = (f32x2e){(p0.x + p1.x) + (p2.x + p3.x), (p0.y + p1.y) + (p2.y + p3.y)}; }
    }
};

struct EpiSwiGLU {
    static constexpr bool PERM = true, AFTER_DRAIN = false;
    PG8_GAS unsigned char* HID;
    const PG8_GAS f32x2e* ST; const PG8_GAS float* c1; const PG8_GAS float* c2; PG8_LAS unsigned char* lds; int tid;
    __device__ __forceinline__ void operator()(const f32x4 (&acc)[2][2][4][2], const Unit& u, int wr, int wc, int fr, int fq) const {
        typedef unsigned u32x2e __attribute__((ext_vector_type(2)));
        PG8_LAS f32x2e* tbl = (PG8_LAS f32x2e*)(lds + 133120);
        if (u.seg == 0) row_stats_table(ST, u.pm, tbl, tid);
        const int cp = u.pn * BM + wc * 32 + 8 * fq;
        f32x4 ca1[2], ca2[2], cb1[2], cb2[2];
#pragma unroll
        for (int n = 0; n < 2; ++n) { ca1[n] = *(const PG8_GAS f32x4*)(c1 + cp + 4 * n); ca2[n] = *(const PG8_GAS f32x4*)(c2 + cp + 4 * n); cb1[n] = *(const PG8_GAS f32x4*)(c1 + cp + HALF + 4 * n); cb2[n] = *(const PG8_GAS f32x4*)(c2 + cp + HALF + 4 * n); }
#pragma unroll
        for (int ai = 0; ai < 2; ++ai)
#pragma unroll
            for (int m = 0; m < 4; ++m) {
                const int rl = ai * HALF + wr * 64 + m * 16 + fr; const f32x2e st = tbl[rl]; const float nm = -st.x;
                u32x2e w;
#pragma unroll
                for (int n = 0; n < 2; ++n) { const f32x4 a = (acc[ai][0][m][n] + ca1[n] * nm) * st.y + ca2[n], b = (acc[ai][1][m][n] + cb1[n] * nm) * st.y + cb2[n];
                    const float h0 = 16.0f * a[0] * fast_sigmoid(a[0]) * b[0], h1 = 16.0f * a[1] * fast_sigmoid(a[1]) * b[1], h2 = 16.0f * a[2] * fast_sigmoid(a[2]) * b[2], h3 = 16.0f * a[3] * fast_sigmoid(a[3]) * b[3];
                    unsigned x = 0u; x = __builtin_amdgcn_cvt_pk_fp8_f32(h0, h1, x, false); x = __builtin_amdgcn_cvt_pk_fp8_f32(h2, h3, x, true); if (n == 0) w.x = x; else w.y = x; }
                *(PG8_GAS u32x2e*)(HID + (size_t)(u.pm * BM + rl) * 5632 + u.pn * 128 + wc * 32 + 8 * fq) = w;
            }
    }
};

struct EpiPlain {
    static constexpr bool PERM = true, AFTER_DRAIN = false;
    PG8_GAS bf16_t* O;
    __device__ __forceinline__ void operator()(const f32x4 (&acc)[2][2][4][2], const Unit& u, int wr, int wc, int fr, int fq) const {
#pragma unroll
        for (int ai = 0; ai < 2; ++ai)
#pragma unroll
            for (int m = 0; m < 4; ++m) {
                const int row = u.pm * BM + ai * HALF + wr * 64 + m * 16 + fr;
#pragma unroll
                for (int bj = 0; bj < 2; ++bj)
                    *(PG8_GAS u32x4*)(O + (size_t)row * 2048 + u.pn * BM + bj * HALF + wc * 32 + 8 * fq) = pack8(acc[ai][bj][m][0], acc[ai][bj][m][1]);
            }
    }
};

struct EpiPleGate {
    static constexpr bool PERM = true, AFTER_DRAIN = false;
    const PG8_GAS _Float16* v2; const PG8_GAS bf16_t* PL; PG8_GAS _Float16* out; PG8_GAS float* outf; PG8_GAS bf16_t* outb; PG8_GAS unsigned char* outb8;
    const PG8_GAS f32x2e* ST; const PG8_GAS float* g2; const PG8_GAS float* b2; const PG8_GAS float* c1; const PG8_GAS float* c2; PG8_LAS unsigned char* lds; int tid;
    __device__ __forceinline__ void operator()(const f32x4 (&acc)[2][2][4][2], const Unit& u, int wr, int wc, int fr, int fq) const {
        typedef unsigned u32x2e __attribute__((ext_vector_type(2)));
        PG8_LAS f32x2e* tbl = (PG8_LAS f32x2e*)(lds + 133120);
        row_stats_table(ST, u.pm, tbl, tid);
        const int col0 = u.pn * BM + wc * 32 + 8 * fq;
#pragma unroll
        for (int bj = 0; bj < 2; ++bj) {
            const int col = col0 + bj * HALF;
            f32x4 gg[2], bb[2], k1[2], k2[2];
#pragma unroll
            for (int n = 0; n < 2; ++n) { gg[n] = *(const PG8_GAS f32x4*)(g2 + col + 4 * n); bb[n] = *(const PG8_GAS f32x4*)(b2 + col + 4 * n); k1[n] = *(const PG8_GAS f32x4*)(c1 + col + 4 * n); k2[n] = *(const PG8_GAS f32x4*)(c2 + col + 4 * n); }
#pragma unroll
            for (int ai = 0; ai < 2; ++ai)
#pragma unroll
                for (int mp = 0; mp < 2; ++mp) {
                    const int rl0 = ai * HALF + wr * 64 + mp * 32 + fr;
                    u32x4 pl[2]; f32x4 r[2][2];
#pragma unroll
                    for (int mm = 0; mm < 2; ++mm) { const size_t off = (size_t)(u.pm * BM + rl0 + mm * 16) * 2048 + col; pl[mm] = *(const PG8_GAS u32x4*)(PL + off); ld_h8(v2 + off, r[mm][0], r[mm][1]); }
                    asm volatile("" ::: "memory");
#pragma unroll
                    for (int mm = 0; mm < 2; ++mm) { const size_t off = (size_t)(u.pm * BM + rl0 + mm * 16) * 2048 + col; const int m = 2 * mp + mm; const f32x2e st = tbl[rl0 + mm * 16]; const float nm = -st.x;
                        f32x4 r0 = (r[mm][0] - st.x) * st.y * gg[0] + bb[0], r1 = (r[mm][1] - st.x) * st.y * gg[1] + bb[1];
                        const f32x4 a0 = (acc[ai][bj][m][0] + k1[0] * nm) * st.y + k2[0], a1 = (acc[ai][bj][m][1] + k1[1] * nm) * st.y + k2[1];
                        const u32x4 p = pl[mm];
                        r0[0] += bf_lo(p.x) * fast_sigmoid(a0[0]); r0[1] += bf_hi(p.x) * fast_sigmoid(a0[1]); r0[2] += bf_lo(p.y) * fast_sigmoid(a0[2]); r0[3] += bf_hi(p.y) * fast_sigmoid(a0[3]);
                        r1[0] += bf_lo(p.z) * fast_sigmoid(a1[0]); r1[1] += bf_hi(p.z) * fast_sigmoid(a1[1]); r1[2] += bf_lo(p.w) * fast_sigmoid(a1[2]); r1[3] += bf_hi(p.w) * fast_sigmoid(a1[3]);
                        if (outf) { *(PG8_GAS f32x4*)(outf + off) = r0; *(PG8_GAS f32x4*)(outf + off + 4) = r1; } else st_h8(out + off, r0, r1);
                        if (outf) continue;
                        *(PG8_GAS u32x4*)(outb + off) = pack8(r0, r1);
                        u32x2e w8; unsigned x = 0u; x = __builtin_amdgcn_cvt_pk_fp8_f32(r0[0], r0[1], x, false); x = __builtin_amdgcn_cvt_pk_fp8_f32(r0[2], r0[3], x, true); w8.x = x;
                        x = 0u; x = __builtin_amdgcn_cvt_pk_fp8_f32(r1[0], r1[1], x, false); x = __builtin_amdgcn_cvt_pk_fp8_f32(r1[2], r1[3], x, true); w8.y = x; *(PG8_GAS u32x2e*)(outb8 + off) = w8; }
                    asm volatile("" ::: "memory");
                }
        }
    }
};
template <class Epi> struct EpiKeeps { static __device__ __forceinline__ bool get(const Unit&) { return false; } };
template <> struct EpiKeeps<EpiBranchSeg> { static __device__ __forceinline__ bool get(const Unit& u) { return EpiBranchSeg::keeps(u); } };
template <class Epi> __device__ __forceinline__ bool epi_keeps_acc(const Unit& u) { return EpiKeeps<Epi>::get(u); }
template <class Epi, class Sched, bool ALIGN_EPI = false, bool SP2 = false, bool FP8 = false, class GemmT = Gemm>
__device__ __forceinline__ void gemm_phase(PG8_LAS unsigned char* lds, const GemmT g, const Sched& S, const Epi& E, const int wave_id) {
    int wid_ = wave_id; asm volatile("" : "+s"(wid_)); int lane_ = (int)__builtin_amdgcn_mbcnt_hi(~0u, __builtin_amdgcn_mbcnt_lo(~0u, 0u)); asm volatile("" : "+v"(lane_)); const int wid = wid_, lane = lane_, tid = wid * 64 + lane, wr = wid >> 2, wc = wid & 3, fr = lane & 15, fq = lane >> 4;
    const int K = gm_ld(g);
    unsigned voffA[2], voffB[2];
#pragma unroll
    for (int i = 0; i < 2; ++i) { int R, C; stage_rc(tid * 16 + i * 8192, R, C); const int Rb = Epi::PERM ? ((R & ~31) + perm32(R & 31)) : R;
        voffA[i] = (unsigned)(R * K + C) * 2u; voffB[i] = (unsigned)(Rb * K + C) * 2u; }
    const size_t kstep = (size_t)(BK * 2);
    const size_t hstep = (size_t)HALF * K * 2;
    const size_t tstep = 2 * hstep;
    const unsigned ldsw = (unsigned)wid * 1024u;
    const int aoff = lds_byte(wr * 64 + fr, fq * 8), boff = lds_byte(wc * 32 + fr, fq * 8);
#define PG8_SA(b, h) (((b) * 2 + (h)) * HTB)
#define PG8_SB(b, h) ((4 + (b) * 2 + (h)) * HTB)
#define PG8_STAGE(bufoff, gbase, voff) do { _Pragma("unroll") for (int _i = 0; _i < 2; ++_i) \
        __builtin_amdgcn_global_load_lds((const unsigned*)((const char*)(gbase) + (voff)[_i]), (PG8_LAS unsigned*)(lds + (bufoff) + ldsw + _i * 8192), 16, 0, 0); } while (0)
#define PG8_LDA(dst, b, h) do { if constexpr (FP8) { _Pragma("unroll") for (int m = 0; m < 4; ++m) { const v4i_t lo_ = *(const PG8_LAS v4i_t*)(lds + PG8_SA(b, h) + aoff + m * 2048), hi_ = *(const PG8_LAS v4i_t*)(lds + PG8_SA(b, h) + aoff + m * 2048 + 1024); dst##8[m] = __builtin_shufflevector(lo_, hi_, 0, 1, 2, 3, 4, 5, 6, 7); } } \
        else { _Pragma("unroll") for (int m = 0; m < 4; ++m) _Pragma("unroll") for (int k = 0; k < 2; ++k) dst[m][k] = *(const PG8_LAS bf16x8*)(lds + PG8_SA(b, h) + aoff + m * 2048 + k * 1024); } } while (0)
#define PG8_LDB(dst, b, h) do { if constexpr (FP8) { _Pragma("unroll") for (int n = 0; n < 2; ++n) { const v4i_t lo_ = *(const PG8_LAS v4i_t*)(lds + PG8_SB(b, h) + boff + n * 2048), hi_ = *(const PG8_LAS v4i_t*)(lds + PG8_SB(b, h) + boff + n * 2048 + 1024); dst##8[n] = __builtin_shufflevector(lo_, hi_, 0, 1, 2, 3, 4, 5, 6, 7); } } \
        else { _Pragma("unroll") for (int n = 0; n < 2; ++n) _Pragma("unroll") for (int k = 0; k < 2; ++k) dst[n][k] = *(const PG8_LAS bf16x8*)(lds + PG8_SB(b, h) + boff + n * 2048 + k * 1024); } } while (0)
#define PG8_MMA(ai, bj, At, Bt) do { __builtin_amdgcn_s_setprio(1); \
        if constexpr (FP8) { _Pragma("unroll") for (int m = 0; m < 4; ++m) _Pragma("unroll") for (int n = 0; n < 2; ++n) \
            asm volatile("v_mfma_scale_f32_16x16x128_f8f6f4 %0, %1, %2, %0, %3, %4 op_sel_hi:[0,0,0]" : "+v"(acc[ai][bj][m][n]) : "v"(Bt##8[n]), "v"(At##8[m]), "v"(sB_), "v"(sA_)); } \
        else { _Pragma("unroll") for (int m = 0; m < 4; ++m) _Pragma("unroll") for (int n = 0; n < 2; ++n) _Pragma("unroll") for (int k = 0; k < 2; ++k) \
            acc[ai][bj][m][n] = __builtin_amdgcn_mfma_f32_16x16x32_bf16(Bt[n][k], At[m][k], acc[ai][bj][m][n], 0, 0, 0); } \
        __builtin_amdgcn_s_setprio(0); } while (0)
#define PG8_WAIT_V(n) asm volatile("s_waitcnt vmcnt(" #n ")" ::: "memory")
#define PG8_WAIT_L(n) asm volatile("s_waitcnt lgkmcnt(" #n ")" ::: "memory")
#define PG8_BAR __builtin_amdgcn_s_barrier()
#define PG8_SCHED __builtin_amdgcn_sched_barrier(0)
    Unit cur, nxt; int ui = 0;
    if (!S.next(0, cur)) return;
    int nt = gm_nt(g, cur.seg);
    f32x4 acc[2][2][4][2];
#pragma unroll
    for (int a = 0; a < 2; ++a)
#pragma unroll
        for (int b = 0; b < 2; ++b)
#pragma unroll
            for (int m = 0; m < 4; ++m)
#pragma unroll
                for (int n = 0; n < 2; ++n) acc[a][b][m][n] = (f32x4){0.f, 0.f, 0.f, 0.f};
    int sA_ = 0, sB_ = 0;
    if constexpr (FP8) asm volatile("v_mov_b32 %0, %2\n\tv_mov_b32 %1, %3\n\ts_nop 7" : "=v"(sA_), "=v"(sB_) : "s"(g.sA), "s"(g.sB));
    bf16x8 At[4][2], B0[2][2], B1[2][2]; v8i_t At8[4], B08[2], B18[2];
    const char* cA = gm_a(g, cur.seg) + (size_t)cur.pm * tstep; const char* cB = gm_b(g, cur.seg) + (size_t)cur.pn * tstep;
    S.a_ready(cur);
    if constexpr (SP2) {
        PG8_STAGE(PG8_SB(0, 0), cB, voffB); PG8_STAGE(PG8_SB(0, 1), cB + hstep, voffB); PG8_STAGE(PG8_SA(0, 0), cA, voffA); PG8_STAGE(PG8_SA(0, 1), cA + hstep, voffA);
        if (wr == 1) PG8_BAR;
        PG8_WAIT_V(2); PG8_BAR;
        PG8_STAGE(PG8_SB(1, 0), cB + kstep, voffB); PG8_STAGE(PG8_SA(1, 0), cA + kstep, voffA); PG8_STAGE(PG8_SB(1, 1), cB + hstep + kstep, voffB);
        PG8_WAIT_V(6); PG8_BAR;
    } else {
        PG8_STAGE(PG8_SB(0, 0), cB, voffB); PG8_STAGE(PG8_SA(0, 0), cA, voffA); PG8_STAGE(PG8_SB(0, 1), cB + hstep, voffB); PG8_STAGE(PG8_SA(0, 1), cA + hstep, voffA);
        if (wr == 1) PG8_BAR;
        PG8_WAIT_V(4); PG8_BAR;
        PG8_STAGE(PG8_SB(1, 0), cB + kstep, voffB); PG8_STAGE(PG8_SA(1, 0), cA + kstep, voffA); PG8_STAGE(PG8_SB(1, 1), cB + hstep + kstep, voffB);
        PG8_WAIT_V(6); PG8_BAR;
    }
    for (;;) {
        const bool has_next = S.next(ui + 1, nxt);
        const char* nA = has_next ? gm_a(g, nxt.seg) + (size_t)nxt.pm * tstep : cA; const char* nB = has_next ? gm_b(g, nxt.seg) + (size_t)nxt.pn * tstep : cB;
        for (int t = 0; t < nt; t += 2) {
            const bool last = (t == nt - 2);
            const char* a1 = cA + (size_t)(t + 1) * kstep;
            const char* a2 = last ? nA : cA + (size_t)(t + 2) * kstep; const char* b2 = last ? nB : cB + (size_t)(t + 2) * kstep;
            const char* a3 = a2 + kstep; const char* b3 = b2 + kstep;
            if (last && has_next) S.a_ready(nxt);
            if constexpr (SP2) {
            PG8_LDB(B0, 0, 0); PG8_LDB(B1, 0, 1); PG8_SCHED; PG8_LDA(At, 0, 0); PG8_STAGE(PG8_SA(1, 1), a1 + hstep, voffA);
            PG8_WAIT_V(8); PG8_WAIT_L(0); PG8_BAR; PG8_MMA(0, 0, At, B0); PG8_MMA(0, 1, At, B1); PG8_BAR; PG8_SCHED;
            PG8_LDA(At, 0, 1); PG8_STAGE(PG8_SB(0, 0), b2, voffB); PG8_STAGE(PG8_SB(0, 1), b2 + hstep, voffB); PG8_STAGE(PG8_SA(0, 0), a2, voffA);
            PG8_WAIT_V(8); PG8_WAIT_L(0); PG8_BAR; PG8_MMA(1, 0, At, B0); PG8_MMA(1, 1, At, B1); PG8_BAR; PG8_SCHED;
            PG8_LDB(B0, 1, 0); PG8_LDB(B1, 1, 1); PG8_SCHED; PG8_LDA(At, 1, 0); PG8_STAGE(PG8_SA(0, 1), a2 + hstep, voffA);
            PG8_WAIT_V(8); PG8_WAIT_L(0); PG8_BAR; PG8_MMA(0, 0, At, B0); PG8_MMA(0, 1, At, B1); PG8_BAR; PG8_SCHED;
            PG8_LDA(At, 1, 1); PG8_STAGE(PG8_SB(1, 0), b3, voffB); PG8_STAGE(PG8_SB(1, 1), b3 + hstep, voffB); PG8_STAGE(PG8_SA(1, 0), a3, voffA);
            PG8_WAIT_V(8); PG8_WAIT_L(0); PG8_BAR; PG8_MMA(1, 0, At, B0); PG8_MMA(1, 1, At, B1); PG8_BAR; PG8_SCHED;
            } else {
            PG8_LDB(B0, 0, 0); PG8_SCHED; PG8_LDA(At, 0, 0); PG8_STAGE(PG8_SA(1, 1), a1 + hstep, voffA);
            PG8_WAIT_L(8); PG8_BAR; PG8_WAIT_L(0); PG8_MMA(0, 0, At, B0); PG8_BAR; PG8_SCHED;
            PG8_LDB(B1, 0, 1); PG8_STAGE(PG8_SB(0, 0), b2, voffB);
            PG8_BAR; PG8_WAIT_L(0); PG8_MMA(0, 1, At, B1); PG8_BAR;
            PG8_LDA(At, 0, 1); PG8_STAGE(PG8_SA(0, 0), a2, voffA);
            PG8_BAR; PG8_WAIT_L(0); PG8_MMA(1, 0, At, B0); PG8_BAR; PG8_SCHED;
            PG8_STAGE(PG8_SB(0, 1), b2 + hstep, voffB);
            PG8_WAIT_V(6); PG8_BAR; PG8_MMA(1, 1, At, B1); PG8_BAR;
            PG8_LDB(B0, 1, 0); PG8_SCHED; PG8_LDA(At, 1, 0); PG8_STAGE(PG8_SA(0, 1), a2 + hstep, voffA);
            PG8_WAIT_L(8); PG8_BAR; PG8_WAIT_L(0); PG8_MMA(0, 0, At, B0); PG8_BAR; PG8_SCHED;
            PG8_LDB(B1, 1, 1); PG8_STAGE(PG8_SB(1, 0), b3, voffB);
            PG8_BAR; PG8_WAIT_L(0); PG8_MMA(0, 1, At, B1); PG8_BAR;
            PG8_LDA(At, 1, 1); PG8_STAGE(PG8_SA(1, 0), a3, voffA);
            PG8_BAR; PG8_WAIT_L(0); PG8_MMA(1, 0, At, B0); PG8_BAR; PG8_SCHED;
            PG8_STAGE(PG8_SB(1, 1), b3 + hstep, voffB);
            PG8_WAIT_V(6); PG8_BAR; PG8_MMA(1, 1, At, B1); PG8_BAR;
            }
        }
        if constexpr (FP8) {
            asm volatile("s_nop 15\n\ts_nop 15\n\ts_nop 7" ::: "memory");
#pragma unroll
            for (int a_ = 0; a_ < 2; ++a_)
#pragma unroll
                for (int b_ = 0; b_ < 2; ++b_)
                    asm volatile("" : "+v"(acc[a_][b_][0][0]), "+v"(acc[a_][b_][0][1]), "+v"(acc[a_][b_][1][0]), "+v"(acc[a_][b_][1][1]), "+v"(acc[a_][b_][2][0]), "+v"(acc[a_][b_][2][1]), "+v"(acc[a_][b_][3][0]), "+v"(acc[a_][b_][3][1]));
        }
        if constexpr (ALIGN_EPI) { if (wr == 0) PG8_BAR; }
        if constexpr (!Epi::AFTER_DRAIN) { int fr2_ = fr, fq2_ = fq; asm volatile("" : "+v"(fr2_), "+v"(fq2_)); E(acc, cur, wr, wc, fr2_, fq2_); S.done(cur); }
        if (!has_next) break;
        if (!epi_keeps_acc<Epi>(cur)) {
#pragma unroll
        for (int a = 0; a < 2; ++a)
#pragma unroll
            for (int b = 0; b < 2; ++b)
#pragma unroll
                for (int m = 0; m < 4; ++m)
#pragma unroll
                    for (int n = 0; n < 2; ++n) acc[a][b][m][n] = (f32x4){0.f, 0.f, 0.f, 0.f};
        }
        cur = nxt; cA = nA; cB = nB; ++ui; nt = gm_nt(g, cur.seg);
        if constexpr (ALIGN_EPI) { if (wr == 1) PG8_BAR; }
    }
    PG8_WAIT_V(0);
    if constexpr (!ALIGN_EPI) { if (wr == 0) PG8_BAR; }
    PG8_BAR;
    if constexpr (Epi::AFTER_DRAIN) { E.fused(acc, cur, wr, wc, fr, fq, lds, wid, lane); S.done(cur); }
#undef PG8_SA
#undef PG8_SB
#undef PG8_STAGE
#undef PG8_LDA
#undef PG8_LDB
#undef PG8_MMA
#undef PG8_WAIT_V
#undef PG8_WAIT_L
#undef PG8_BAR
#undef PG8_SCHED
}
}
constexpr int NB = 4, SEQ = 2048, DM = 2048, NL = 4, MTOK = NB * SEQ;
constexpr int ZC = 12032, IN_COLS = 11874, DFF = 5632;
constexpr float ALPHA_F = 1.681792830507429f;
constexpr int NWAVES = 8;

constexpr size_t MiB = 1u << 20;
constexpr size_t WS_CTL = 0, CTL_ZERO_BYTES = 64 * 1024;
constexpr size_t WS_ROPE128 = 1 * MiB, WS_ROPE64 = 2 * MiB;
constexpr size_t WS_W = 3 * MiB, W_LAYER = 148 * MiB;
constexpr size_t WO_IN = 0;
constexpr size_t WO_ING8 = WO_IN + (size_t)5888 * 2048 * 2;
constexpr size_t WO_BRF = WO_IN + (size_t)ZC * 2048 * 2;
constexpr size_t WO_BRN = WO_BRF + 2048 * 768 * 2;
constexpr size_t WO_BRD = WO_BRN + 2048 * 768 * 2;
constexpr size_t WO_OUT = WO_BRD + 2048 * 768 * 2;
constexpr size_t WO_FFI = WO_OUT + 2048 * 2048 * 2;
constexpr size_t WO_FFO = WO_FFI + (size_t)11264 * 2048 * 2;
constexpr size_t WO_PG = WO_FFO + (size_t)2048 * 5632 * 2;
constexpr size_t WO_PI = WO_PG + 2048 * 2048 * 2;
constexpr size_t WO_CK1 = WO_PI + 2048 * 768 * 2;
constexpr size_t WO_CV1 = WO_CK1 + 256 * 4096 * 2;
constexpr size_t WO_CK2 = WO_CV1 + 256 * 4096 * 2;
constexpr size_t WO_CV2 = WO_CK2 + 128 * 256 * 2;
constexpr size_t WO_KVUP = WO_CV2 + 128 * 256 * 2;
constexpr size_t WO_END = WO_KVUP + 256 * 256 * 2;
static_assert(WO_END <= W_LAYER, "layer weight block");
constexpr size_t WS_ACT = WS_W + NL * W_LAYER;
constexpr size_t A_XB0 = WS_ACT, A_XB1 = A_XB0 + 32 * MiB;
constexpr size_t A_VA = A_XB1 + 32 * MiB;
constexpr size_t A_FQ = A_VA + 64 * MiB, A_FK = A_FQ + 12 * MiB, A_FV = A_FK + 12 * MiB;
constexpr size_t A_NQ = A_FV + 12 * MiB;
constexpr size_t A_KC = A_NQ + 8 * MiB, A_VC = A_KC + 2 * MiB, A_KS = A_VC + 2 * MiB, A_VS = A_KS + 2 * MiB, A_KW = A_VS + 2 * MiB, A_VW = A_KW + 2 * MiB;
constexpr size_t A_DQ = A_VW + 2 * MiB;
constexpr size_t A_CKV = A_DQ + 12 * MiB;
constexpr size_t A_IQ = A_CKV + 4 * MiB;
constexpr size_t A_IK = A_IQ + 16 * MiB;
constexpr size_t A_SM = A_IK + 1 * MiB;
constexpr size_t A_G = A_SM + 2 * MiB;
constexpr size_t A_HID = A_G;
constexpr size_t A_KD = A_G + 96 * MiB, A_VD = A_KD + 2 * MiB;
constexpr size_t A_SC = A_VD + 2 * MiB;
constexpr size_t A_MIXF = A_SC;
constexpr size_t A_BM = A_SC + 64 * MiB;
constexpr size_t A_HC = A_BM + 2 * MiB;
constexpr size_t A_KCMP = A_HC + 1 * MiB, A_VCMP = A_KCMP + 512 * 1024;
constexpr size_t A_OF = A_VCMP + 512 * 1024, A_ON = A_OF + 12 * MiB, A_OD = A_ON + 12 * MiB;
constexpr size_t A_MIXB = A_OD + 12 * MiB;
constexpr size_t A_PLB = A_MIXB + 32 * MiB;
constexpr size_t A_PB = A_PLB + 32 * MiB;
constexpr size_t A_OCS = A_PB + 48 * MiB;
constexpr size_t A_X8 = A_OCS + 16 * MiB;
constexpr size_t A_CBP = A_X8 + 16 * MiB;
constexpr size_t A_X8B = A_CBP + 1 * MiB;
constexpr size_t A_ST1 = A_X8B + 16 * MiB, A_ST2 = A_ST1 + 4 * MiB;
constexpr size_t A_CV = A_ST2 + 4 * MiB;
constexpr int CV_LAYER = 2 * 11264 + 2 * 2048;
constexpr size_t WS_END = A_CV + 1 * MiB;
constexpr int CW_TMO = 0, CW_CODE = 1;
constexpr int CW_Q = 64;
constexpr int CW_BAR = 4096;
constexpr int CW_CMPB = 8192;
constexpr int CW_FLAG = CW_CMPB + NL * 2 * 256;
static_assert((CW_FLAG + NL * 320) * 4 <= (int)CTL_ZERO_BYTES, "ctl");
constexpr int RING_OFF = 0, RING_BYTES = 131072;
constexpr int LDSCTL_OFF = 147456 - 1024, MISC_OFF = LDSCTL_OFF + 320;
constexpr int LDS_BYTES = 147456;
constexpr int LDS_STAT = 133120;

#define GAS __attribute__((address_space(1)))
#define LAS __attribute__((address_space(3)))
#define DI __device__ __forceinline__
typedef unsigned short bf16;
typedef unsigned v4u __attribute__((ext_vector_type(4)));
typedef unsigned v2u __attribute__((ext_vector_type(2)));
typedef float f32x4 __attribute__((ext_vector_type(4)));
typedef float f32x2 __attribute__((ext_vector_type(2)));
typedef float f32x16 __attribute__((ext_vector_type(16)));
typedef short bf16x8 __attribute__((ext_vector_type(8)));
typedef short s16x4 __attribute__((ext_vector_type(4)));
typedef GAS unsigned gu32;
#define RLX_AGENT __ATOMIC_RELAXED, __HIP_MEMORY_SCOPE_AGENT
#define LDS_WAIT() asm volatile("s_waitcnt lgkmcnt(0)" ::: "memory")
#define VM_WAIT() asm volatile("s_waitcnt vmcnt(0)" ::: "memory")
DI unsigned f2bf(float f) { unsigned u = __builtin_bit_cast(unsigned, f); return (u + 0x7fffu + ((u >> 16) & 1u)) >> 16; }
DI unsigned pk2(float lo, float hi) { return f2bf(lo) | (f2bf(hi) << 16); }
typedef __bf16 bf16x2_t __attribute__((ext_vector_type(2)));
DI unsigned cvtpk(float lo, float hi) { f32x2 v = {lo, hi}; bf16x2_t b = __builtin_convertvector(v, bf16x2_t); return __builtin_bit_cast(unsigned, b); }
DI float bfl(unsigned w) { return __uint_as_float(w << 16); }
DI float bfh(unsigned w) { return __uint_as_float(w & 0xffff0000u); }
DI float ex2(float x) { return __builtin_amdgcn_exp2f(x); }
DI float sigm(float x) { return __builtin_amdgcn_rcpf(1.0f + ex2(-1.4426950408889634f * x)); }
#define XB_TMO      128
#define XB_XCNT(j)  (256  + 64 * (j))
#define XB_XSUB(j)  (1280 + 64 * (j))
#define XB_XGEN(j)  (2304 + 64 * (j))
#define XB_TOP      3328
#define XB_TOPGEN   3392
#define XCD_BAR_WORDS 3456
#define XB_SPIN_CAP (1u << 18)

__device__ __forceinline__ unsigned xb_ld(unsigned* p)              { return __hip_atomic_load(p, __ATOMIC_RELAXED, __HIP_MEMORY_SCOPE_AGENT); }
__device__ __forceinline__ unsigned xb_add(unsigned* p, unsigned v) { return __hip_atomic_fetch_add(p, v, __ATOMIC_RELAXED, __HIP_MEMORY_SCOPE_AGENT); }
__device__ __forceinline__ unsigned xb_xcc_id() { return (unsigned)__builtin_amdgcn_s_getreg((3 << 11) | 20) & 0xFu; }
#define XB_SPIN(cond, bar) do { unsigned _sp = 0; while (cond) { __builtin_amdgcn_s_sleep(1); \
    if ((++_sp & 255u) == 0u) { if (xb_ld(&(bar)[XB_TMO])) break; if (_sp > XB_SPIN_CAP) { atomicAdd(&(bar)[XB_TMO], 1u); break; } } } } while (0)

struct XcdBarrier {
    unsigned* bar; unsigned x;
    volatile LAS unsigned* st;
};

__device__ __forceinline__ XcdBarrier xcd_barrier_post(unsigned* bar, volatile LAS unsigned* st) {
    XcdBarrier b; b.bar = bar; b.x = xb_xcc_id(); b.st = st;
    if (threadIdx.x == 0) (void)xb_add(&bar[XB_XCNT(b.x)], 1u);
    return b;
}
__device__ __forceinline__ void xcd_barrier_complete(unsigned* bar, unsigned x, unsigned& nloc, unsigned& nx) {
    const unsigned G = gridDim.x * gridDim.y * gridDim.z;
    unsigned sum, cnt, mine, sp = 0u;
    for (;;) {
        sum = 0u; cnt = 0u; mine = 0u;
#pragma unroll
        for (unsigned j = 0; j < 16; ++j) { const unsigned c = xb_ld(&bar[XB_XCNT(j)]); sum += c; cnt += (c > 0u) ? 1u : 0u; mine = (j == x) ? c : mine; }
        if (sum == G) break;
        __builtin_amdgcn_s_sleep(1);
        if ((++sp & 255u) == 0u) { if (xb_ld(&bar[XB_TMO])) break; if (sp > XB_SPIN_CAP) { atomicAdd(&bar[XB_TMO], 1u); break; } }
    }
    nloc = mine > 0u ? mine : 1u; nx = cnt > 0u ? cnt : 1u;
}

__device__ __forceinline__ void xcd_barrier(const XcdBarrier& b) {
    asm volatile("s_waitcnt vmcnt(0)" ::: "memory");
    __syncthreads();
    if (threadIdx.x == 0) {
        unsigned* bar = b.bar;
        __builtin_amdgcn_s_waitcnt(0);
        unsigned nloc = b.st[0], nx = b.st[1];
        if (nloc == 0u) { xcd_barrier_complete(bar, b.x, nloc, nx); b.st[0] = nloc; b.st[1] = nx; }
        const unsigned old = xb_add(&bar[XB_XSUB(b.x)], 1u);
        const unsigned gen = old / nloc;
        if (old + 1u == (gen + 1u) * nloc) {
            __builtin_amdgcn_fence(__ATOMIC_RELEASE, "agent");
            asm volatile("s_waitcnt vmcnt(0)" ::: "memory");
            const unsigned og = xb_add(&bar[XB_TOP], 1u);
            const unsigned tg = og / nx;
            if (og + 1u == (tg + 1u) * nx) xb_add(&bar[XB_TOPGEN], 1u);
            else XB_SPIN(xb_ld(&bar[XB_TOPGEN]) == tg, bar);
            __builtin_amdgcn_fence(__ATOMIC_ACQUIRE, "agent");
            xb_add(&bar[XB_XGEN(b.x)], 1u);
            asm volatile("s_waitcnt vmcnt(0)" ::: "memory");
        } else {
            XB_SPIN(xb_ld(&bar[XB_XGEN(b.x)]) == gen, bar);
            __builtin_amdgcn_fence(__ATOMIC_ACQUIRE, "agent");
            asm volatile("s_waitcnt vmcnt(0)" ::: "memory");
        }
    }
    __syncthreads();
}
struct Frame {
    LAS unsigned char* lds;
    volatile LAS unsigned* MISC;
    gu32* ctl;
    GAS unsigned char* ws;
    int tid, lane, wave;
    int vcu, G;
};
DI float wave_sum(float v) {
#pragma unroll
    for (int o = 1; o < 64; o <<= 1) v += __shfl_xor(v, o);
    return v;
}
DI int q_next(Frame& F, gu32* head) {
    if (F.tid == 0) F.MISC[4] = __hip_atomic_fetch_add(head, 1u, RLX_AGENT);
    __syncthreads();
    const int v = (int)F.MISC[4];
    __syncthreads();
    return v;
}

DI void unit_done(Frame& F, gu32* flag) {
    asm volatile("s_waitcnt vmcnt(0)" ::: "memory"); __syncthreads();
    if (F.tid == 0) { __builtin_amdgcn_fence(__ATOMIC_RELEASE, "agent"); asm volatile("s_waitcnt vmcnt(0)" ::: "memory"); (void)__hip_atomic_fetch_add(flag, 1u, RLX_AGENT); }
}
DI void unit_wait(Frame& F, gu32* f0, gu32* f1, unsigned need) {
    if (F.tid == 0) { unsigned* bar = (unsigned*)(F.ctl + CW_BAR);
        XB_SPIN(__hip_atomic_load(f0, RLX_AGENT) < need, bar); XB_SPIN(__hip_atomic_load(f1, RLX_AGENT) < need, bar);
        __builtin_amdgcn_fence(__ATOMIC_ACQUIRE, "agent"); asm volatile("s_waitcnt vmcnt(0)" ::: "memory"); }
    __syncthreads();
}
DI int deint128(int p) { return (p >> 1) + 64 * (p & 1); }
DI int deint64(int p) { return (p >> 1) + 32 * (p & 1); }
DI int win_src(int n) {
    if (n < 2304) return n;
    if (n < 2816) { const int p = n - 2304; return 2310 + (p & ~127) + deint128(p & 127); }
    if (n < 2944) return 2822 + (n - 2816);
    if (n < 3072) return 2950 + (n - 2944);
    if (n < 3200) return 3078 + deint128(n - 3072);
    if (n < 3328) return 3206 + (n - 3200);
    if (n < 3456) return 3334 + deint128(n - 3328);
    if (n < 3584) return 3462 + (n - 3456);
    if (n < 4352) { const int p = n - 3584; return 3602 + (p & ~127) + deint128(p & 127); }
    if (n < 4608) return 4370 + (n - 4352);
    if (n < 5632) { const int p = n - 4608; return 4626 + (p & ~63) + deint64(p & 63); }
    if (n < 5696) return 5650 + deint64(n - 5632);
    if (n < 5702) return 2304 + (n - 5696);
    if (n < 5714) return 3590 + (n - 5702);
    if (n < 5730) return 5714 + (n - 5714);
    if (n < 5888) return -1;
    return 5730 + (n - 5888);
}
DI unsigned pk4_fp8(float a, float b, float c, float d) { unsigned w = 0u; w = __builtin_amdgcn_cvt_pk_fp8_f32(a, b, w, false); w = __builtin_amdgcn_cvt_pk_fp8_f32(c, d, w, true); return w; }
DI int int128(int w) { return w < 64 ? 2 * w : 2 * (w - 64) + 1; }
DI int int64(int w) { return w < 32 ? 2 * w : 2 * (w - 32) + 1; }
DI int win_dst(int s) {
    if (s < 2304) return s;
    if (s < 2310) return 5696 + (s - 2304);
    if (s < 2822) { const int p = s - 2310; return 2304 + (p & ~127) + int128(p & 127); }
    if (s < 2950) return 2816 + (s - 2822);
    if (s < 3078) return 2944 + (s - 2950);
    if (s < 3206) return 3072 + int128(s - 3078);
    if (s < 3334) return 3200 + (s - 3206);
    if (s < 3462) return 3328 + int128(s - 3334);
    if (s < 3590) return 3456 + (s - 3462);
    if (s < 3602) return 5702 + (s - 3590);
    if (s < 4370) { const int p = s - 3602; return 3584 + (p & ~127) + int128(p & 127); }
    if (s < 4626) return 4352 + (s - 4370);
    if (s < 5650) { const int p = s - 4626; return 4608 + (p & ~63) + int64(p & 63); }
    if (s < 5714) return 5632 + int64(s - 5650);
    if (s < 5730) return s;
    return -1;
}
DI int dmap(int kind, int s) {
    if (kind == 0) return s;
    if (kind == 1 || kind == 6) {
        const int n = s < 5730 ? win_dst(s) : 5888 + (s - 5730); if (n < 0) return -1;
        const int t = n >> 8; const bool isa = t < 6 || t == 9 || t == 10 || (t >= 14 && t <= 16) || (t >= 18 && t <= 22);
        if (kind == 1) return isa ? ((t < 6 ? t : t < 11 ? t - 3 : t < 17 ? t - 6 : t - 7) << 8) + (n & 255) : -1;
        return isa ? -1 : ((t >= 23 ? t - 23 : t <= 8 ? t + 18 : t <= 13 ? t + 16 : 30) << 8) + (n & 255);
    }
    if (kind == 2) return s - 5730;
    if (kind == 3) { const int half = s >= DFF ? 1 : 0, j = s - half * DFF; return ((j >> 7) << 8) + half * 128 + (j & 127); }
    if (kind == 4) return int128(s);
    return s < 128 ? int128(s) : s;
}
typedef float f32x4u __attribute__((ext_vector_type(4), aligned(4)));
struct TrP { const GAS float* W; GAS unsigned char* WT; const GAS float* kscale; int Nsrc, k0, s0, ldw, kind; bool f8; float sc; bool skip; };
DI void tr_load(const TrP& t, int lane, f32x4 (&v)[16]) {
    const int kr = lane >> 4, c4 = lane & 15;
    const GAS float* src = t.W + (size_t)(t.k0 + kr) * t.Nsrc + t.s0 + 4 * c4;
#pragma unroll
    for (int i = 0; i < 16; ++i) v[i] = *(const GAS f32x4u*)(src + (size_t)(4 * i) * t.Nsrc);
}
DI void tr_finish(const TrP& t, const f32x4 (&v)[16], LAS float* scr, int lane) {
    const int kr = lane >> 4, c4 = lane & 15; const int k0 = t.k0, s0 = t.s0, ldw = t.ldw, kind = t.kind; const float sc = t.sc; const GAS float* kscale = t.kscale; GAS unsigned char* WT = t.WT;
#pragma unroll
    for (int i = 0; i < 16; ++i) { const float ks = kscale ? kscale[k0 + 4 * i + kr] * sc : sc; LAS float* d = scr + (4 * i + kr) * 65 + 4 * c4;
        d[0] = v[i][0] * ks; d[1] = v[i][1] * ks; d[2] = v[i][2] * ks; d[3] = v[i][3] * ks; }
    LDS_WAIT(); asm volatile("" ::: "memory");
    if (t.f8) {
#pragma unroll
        for (int p = 0; p < 4; ++p) { const int r = 16 * p + (lane >> 2), ch = lane & 3, n = dmap(kind, s0 + r); const LAS float* s = scr + (16 * ch) * 65 + r;
            v4u o; o.x = pk4_fp8(s[0], s[65], s[130], s[195]); o.y = pk4_fp8(s[260], s[325], s[390], s[455]); o.z = pk4_fp8(s[520], s[585], s[650], s[715]); o.w = pk4_fp8(s[780], s[845], s[910], s[975]);
            if (n >= 0) *(GAS v4u*)(WT + (size_t)n * ldw + k0 + 16 * ch) = o; }
    } else {
#pragma unroll
        for (int p = 0; p < 8; ++p) { const int r = 8 * p + (lane >> 3), ch = lane & 7, n = dmap(kind, s0 + r); const LAS float* s = scr + (8 * ch) * 65 + r;
            v4u o; o.x = cvtpk(s[0], s[65]); o.y = cvtpk(s[130], s[195]); o.z = cvtpk(s[260], s[325]); o.w = cvtpk(s[390], s[455]);
            if (n >= 0) *(GAS v4u*)(WT + ((size_t)n * ldw + k0 + 8 * ch) * 2) = o; }
    }
    LDS_WAIT(); asm volatile("" ::: "memory");
}
DI void sincos_d(double a, double& s, double& c) {
    const double k = __builtin_rint(a * 0.63661977236758134308);
    double r = a - k * 1.57079632679489655800e+00; r -= k * 6.12323399573676603587e-17;
    const double r2 = r * r;
    double sp = -7.6471637318198164759e-13; sp = sp * r2 + 1.6059043836821614599e-10; sp = sp * r2 - 2.5052108385441718775e-08; sp = sp * r2 + 2.7557319223985890653e-06;
    sp = sp * r2 - 1.9841269841269841270e-04; sp = sp * r2 + 8.3333333333333333333e-03; sp = sp * r2 - 1.6666666666666666667e-01; const double sr = r + r * r2 * sp;
    double cp = 4.7794773323873852974e-14; cp = cp * r2 - 1.1470745597729724714e-11; cp = cp * r2 + 2.0876756987868098979e-09; cp = cp * r2 - 2.7557319223985890653e-07;
    cp = cp * r2 + 2.4801587301587301587e-05; cp = cp * r2 - 1.3888888888888888889e-03; cp = cp * r2 + 4.1666666666666666667e-02; cp = cp * r2 - 0.5; const double cr = 1.0 + r2 * cp;
    const int q = ((int)k) & 3;
    s = (q == 0) ? sr : (q == 1) ? cr : (q == 2) ? -sr : -cr;
    c = (q == 0) ? cr : (q == 1) ? -sr : (q == 2) ? -cr : sr;
}
struct Args { const float* in[24]; float* out; unsigned char* ws; int pad0, pad1; };

constexpr int NIT = 2880 + 2880 + 3072 + 384 + 256 + 384 + 1024 + 5632 + 2816 + 1024 + 128 + 256 + 256 + 8 + 8 + 16;
static_assert(NIT == 16 * 1314, "a layer's items are dealt to 1314 workgroup units of 16 (two per wave)");
DI TrP conv_params(const Args& A, int l, int r) {
    const GAS float* W; int K, Nsrc, sbeg, nct, ldw, kind; bool f8 = false; float sc = 1.0f; size_t off; const GAS float* ksc = nullptr;
    if (r < 2880)           { W = (const GAS float*)A.in[2];  K = 2048; Nsrc = IN_COLS; sbeg = 0;    nct = 90;  ldw = 2048; kind = 1; off = WO_IN; }
    else if ((r -= 2880) < 2880) { W = (const GAS float*)A.in[2];  K = 2048; Nsrc = IN_COLS; sbeg = 0;    nct = 90;  ldw = 2048; kind = 6; off = WO_ING8; f8 = true; sc = 32.0f; }
    else if ((r -= 2880) < 3072) { W = (const GAS float*)A.in[2];  K = 2048; Nsrc = IN_COLS; sbeg = 5730; nct = 96;  ldw = 2048; kind = 6; off = WO_ING8; f8 = true; sc = 32.0f; }
    else if ((r -= 3072) < 384)  { W = (const GAS float*)A.in[12]; K = 768;  Nsrc = 2048; sbeg = 0; nct = 32;  ldw = 768;  kind = 0; off = WO_BRF; }
    else if ((r -= 384) < 256)   { W = (const GAS float*)A.in[13]; K = 512;  Nsrc = 2048; sbeg = 0; nct = 32;  ldw = 768;  kind = 0; off = WO_BRN; }
    else if ((r -= 256) < 384)   { W = (const GAS float*)A.in[14]; K = 768;  Nsrc = 2048; sbeg = 0; nct = 32;  ldw = 768;  kind = 0; off = WO_BRD; }
    else if ((r -= 384) < 1024)  { W = (const GAS float*)A.in[15]; K = 2048; Nsrc = 2048; sbeg = 0; nct = 32;  ldw = 2048; kind = 0; off = WO_OUT; }
    else if ((r -= 1024) < 5632) { W = (const GAS float*)A.in[18]; K = 2048; Nsrc = 11264; sbeg = 0; nct = 176; ldw = 2048; kind = 3; off = WO_FFI; f8 = true; sc = 64.0f; }
    else if ((r -= 5632) < 2816) { W = (const GAS float*)A.in[19]; K = 5632; Nsrc = 2048; sbeg = 0; nct = 32;  ldw = 5632; kind = 0; off = WO_FFO; f8 = true; sc = 128.0f; }
    else if ((r -= 2816) < 1024) { W = (const GAS float*)A.in[23]; K = 2048; Nsrc = 2048; sbeg = 0; nct = 32;  ldw = 2048; kind = 0; off = WO_PG; }
    else if ((r -= 1024) < 128)  { W = (const GAS float*)A.in[22]; K = 256;  Nsrc = 2048; sbeg = 0; nct = 32;  ldw = 768;  kind = 0; off = WO_PI; }
    else if ((r -= 128) < 256)   { W = (const GAS float*)A.in[6];  K = 4096; Nsrc = 256;  sbeg = 0; nct = 4;   ldw = 4096; kind = 0; off = WO_CK1; }
    else if ((r -= 256) < 256)   { W = (const GAS float*)A.in[8];  K = 4096; Nsrc = 256;  sbeg = 0; nct = 4;   ldw = 4096; kind = 0; off = WO_CV1; }
    else if ((r -= 256) < 8)     { W = (const GAS float*)A.in[7];  K = 256;  Nsrc = 128;  sbeg = 0; nct = 2;   ldw = 256;  kind = 4; off = WO_CK2; }
    else if ((r -= 8) < 8)       { W = (const GAS float*)A.in[9];  K = 256;  Nsrc = 128;  sbeg = 0; nct = 2;   ldw = 256;  kind = 0; off = WO_CV2; }
    else { r -= 8;         W = (const GAS float*)A.in[11]; K = 256;  Nsrc = 256;  sbeg = 0; nct = 4;   ldw = 256;  kind = 5; off = WO_KVUP; ksc = (const GAS float*)A.in[10] + (size_t)l * 256; }
    bool skip = false;
    if (kind == 1 || (kind == 6 && sbeg == 0)) {
        const int a = 64 * (r % nct), b = a + 63; const bool hit8 = (a < 2304 && b >= 1536) || (a < 3590 && b >= 2822) || (a < 4626 && b >= 4370);
        const bool all8 = (a >= 1536 && b < 2304) || (a >= 2822 && b < 3590) || (a >= 4370 && b < 4626);
        skip = kind == 1 ? all8 : !hit8;
    }
    TrP t; t.W = W + (size_t)l * K * Nsrc; t.skip = skip; t.WT = (GAS unsigned char*)A.ws + WS_W + (size_t)l * W_LAYER + off; t.kscale = ksc; t.Nsrc = Nsrc; t.k0 = 64 * (r / nct); t.s0 = sbeg + 64 * (r % nct); t.ldw = ldw; t.kind = kind; t.f8 = f8; t.sc = sc;
    return t;
}
DI void conv_one(const TrP& t, LAS float* scr, int lane) { f32x4 v[16]; tr_load(t, lane, v); tr_finish(t, v, scr, lane); }
DI void conv_item(Frame& F, const Args& A, int l, int r, LAS float* scr) { const TrP t = conv_params(A, l, r); if (!t.skip) conv_one(t, scr, F.lane); }
DI void conv_item2(Frame& F, const Args& A, int l, int r0, int r1, LAS float* scr) {
    const TrP t0 = conv_params(A, l, r0), t1 = conv_params(A, l, r1);
    if (t0.skip || t1.skip) { if (!t0.skip) conv_one(t0, scr, F.lane); if (!t1.skip) conv_one(t1, scr, F.lane); return; }
    f32x4 v0[16], v1[16];
    tr_load(t0, F.lane, v0); tr_load(t1, F.lane, v1);
    tr_finish(t0, v0, scr, F.lane); tr_finish(t1, v1, scr, F.lane);
}
DI void conv_unit(Frame& F, const Args& A, int l, int c) { conv_item2(F, A, l, c * 16 + F.wave, c * 16 + 8 + F.wave, (LAS float*)(F.lds + RING_OFF + F.wave * 16640)); }
DI void p0_prologue(Frame& F, const Args& A) {
    LAS float* scr = (LAS float*)(F.lds + RING_OFF + F.wave * 16640);
    const int gw = F.vcu * NWAVES + F.wave, NGW = F.G * NWAVES;
    for (int it = gw; it < NIT; it += 2 * NGW) { if (it + NGW < NIT) conv_item2(F, A, 0, it, it + NGW, scr); else conv_item(F, A, 0, it, scr); }
    for (int i = F.vcu * 512 + F.tid; i < NL * 158 * 256; i += F.G * 512) { const int l = i / (158 * 256), rr = i % (158 * 256);
        ((GAS v4u*)(F.ws + WS_W + (size_t)l * W_LAYER + WO_IN + (size_t)(15 * 256 + 98) * 4096))[rr] = (v4u){0u, 0u, 0u, 0u}; }
    const int gt = F.vcu * (NWAVES * 64) + F.tid, NGT = F.G * NWAVES * 64;
    for (int i = gt; i < SEQ * 96; i += NGT) {
        const bool big = i < SEQ * 64; const int ii = big ? i : i - SEQ * 64; const int pos = big ? (ii >> 6) : (ii >> 5), j = big ? (ii & 63) : (ii & 31);
        const double base = big ? 1.1547819846894583 : 1.3335214321633240;
        double t = 1.0; for (int e = 0; e < j; ++e) t *= base;
        const float inv = 1.0f / (float)t; const float ang = (float)pos * inv;
        double s, c; sincos_d((double)ang, s, c);
        GAS f32x2* dst = big ? (GAS f32x2*)(F.ws + WS_ROPE128) + ii : (GAS f32x2*)(F.ws + WS_ROPE64) + ii;
        *dst = (f32x2){(float)c, (float)s};
    }
    { const GAS f32x4* x4 = (const GAS f32x4*)A.in[0]; GAS v2u* o = (GAS v2u*)(F.ws + A_XB0); GAS unsigned* o8 = (GAS unsigned*)(F.ws + A_X8B);
      for (int i = gt; i < MTOK * DM / 4; i += NGT) { const f32x4 v = x4[i]; o[i] = (v2u){pk2(v[0], v[1]), pk2(v[2], v[3])}; o8[i] = pk4_fp8(v[0], v[1], v[2], v[3]);
          { typedef _Float16 h4 __attribute__((ext_vector_type(4))); ((GAS h4*)(F.ws + A_VA))[i] = __builtin_convertvector(v, h4); } }
      const GAS f32x4* p4 = (const GAS f32x4*)A.in[1]; GAS v2u* po = (GAS v2u*)(F.ws + A_PB);
      for (int i = gt; i < NL * MTOK * 256 / 4; i += NGT) { const f32x4 v = p4[i]; po[(size_t)(i >> 6) * 192 + (i & 63)] = (v2u){pk2(v[0], v[1]), pk2(v[2], v[3])}; } }
    for (int it = F.vcu; it < NL * 2 * 32; it += F.G) {
        const int l = it >> 6, kv = (it >> 5) & 1, kc = it & 31, n = F.tid & 255;
        if (F.tid < 256) {
            const GAS float* pe = (const GAS float*)(kv ? A.in[5] : A.in[4]) + (size_t)l * 4096 + kc * 128; const GAS float* w1 = (const GAS float*)(kv ? A.in[8] : A.in[6]) + ((size_t)l * 4096 + kc * 128) * 256 + n;
            float s = 0.f;
#pragma unroll 16
            for (int k = 0; k < 128; ++k) s += pe[k] * w1[(size_t)k * 256];
            ((GAS float*)(F.ws + A_CBP))[(size_t)it * 256 + n] = s;
        }
    }
}

DI void p0_cvec(Frame& F, const Args& A, int l) {
    const int gw = F.vcu * NWAVES + F.wave, NGW = F.G * NWAVES, lane = F.lane;
    GAS float* cv = (GAS float*)(F.ws + A_CV) + (size_t)l * CV_LAYER;
    {
        f32x4 g[8], bb[8];
        const GAS f32x4* g4 = (const GAS f32x4*)((const GAS float*)A.in[16] + (size_t)l * DM + 32 * lane); const GAS f32x4* b4 = (const GAS f32x4*)((const GAS float*)A.in[17] + (size_t)l * DM + 32 * lane);
#pragma unroll
        for (int i = 0; i < 8; ++i) { g[i] = g4[i]; bb[i] = b4[i]; }
        for (int base = gw; base < 11264; base += 6 * NGW) {
            v4u q[6][2];
#pragma unroll
            for (int k = 0; k < 6; ++k) { const int r = base + k * NGW; const GAS v4u* w = (const GAS v4u*)(F.ws + WS_W + (size_t)l * W_LAYER + WO_FFI + (size_t)(r < 11264 ? r : base) * 2048 + 32 * lane); q[k][0] = w[0]; q[k][1] = w[1]; }
#pragma unroll
            for (int k = 0; k < 6; ++k) { const int r = base + k * NGW; float s1 = 0.f, s2 = 0.f;
#pragma unroll
                for (int i = 0; i < 2; ++i)
#pragma unroll
                    for (int j = 0; j < 4; ++j) { const unsigned x = q[k][i][j]; const f32x2 lo = __builtin_amdgcn_cvt_pk_f32_fp8(x, false), hi = __builtin_amdgcn_cvt_pk_f32_fp8(x, true); const f32x4 gg = g[4 * i + j], bv = bb[4 * i + j];
                        s1 += (lo[0] * gg[0] + lo[1] * gg[1]) + (hi[0] * gg[2] + hi[1] * gg[3]); s2 += (lo[0] * bv[0] + lo[1] * bv[1]) + (hi[0] * bv[2] + hi[1] * bv[3]); }
                s1 = wave_sum(s1) * (1.0f / 64.0f); s2 = wave_sum(s2) * (1.0f / 64.0f);
                if (lane == 0 && r < 11264) { cv[r] = s1; cv[11264 + r] = s2; } }
        }
    }
    for (int c = gw; c < 2048; c += NGW) {
        const GAS f32x4* g4 = (const GAS f32x4*)((const GAS float*)A.in[20] + (size_t)l * DM + 32 * lane); const GAS f32x4* b4 = (const GAS f32x4*)((const GAS float*)A.in[21] + (size_t)l * DM + 32 * lane);
        const GAS v4u* w = (const GAS v4u*)(F.ws + WS_W + (size_t)l * W_LAYER + WO_PG + ((size_t)c * 2048 + 32 * lane) * 2);
        float s1 = 0.f, s2 = 0.f;
#pragma unroll
        for (int i = 0; i < 4; ++i) { const v4u q = w[i]; const f32x4 ga = g4[2 * i], gb = g4[2 * i + 1], ba = b4[2 * i], bb = b4[2 * i + 1];
            s1 += (bfl(q.x) * ga[0] + bfh(q.x) * ga[1]) + (bfl(q.y) * ga[2] + bfh(q.y) * ga[3]) + (bfl(q.z) * gb[0] + bfh(q.z) * gb[1]) + (bfl(q.w) * gb[2] + bfh(q.w) * gb[3]);
            s2 += (bfl(q.x) * ba[0] + bfh(q.x) * ba[1]) + (bfl(q.y) * ba[2] + bfh(q.y) * ba[3]) + (bfl(q.z) * bb[0] + bfh(q.z) * bb[1]) + (bfl(q.w) * bb[2] + bfh(q.w) * bb[3]); }
        s1 = wave_sum(s1); s2 = wave_sum(s2);
        if (lane == 0) { cv[22528 + c] = s1; cv[22528 + 2048 + c] = s2; }
    }
}

DI bool unit_poll(Frame& F, gu32* flag, unsigned need) {
    if (F.tid == 0) F.MISC[5] = __hip_atomic_load(flag, RLX_AGENT) >= need ? 1u : 0u;
    __syncthreads(); const bool r = F.MISC[5] != 0u; __syncthreads(); return r;
}
DI bool conv_try(Frame& F, const Args& A, int l, gu32* chead) {
    const int c = q_next(F, chead);
    if (c >= 1314) return false;
    conv_unit(F, A, l, c); return true;
}
template <bool OUT8> DI void ln_rows(Frame& F, const GAS float* in, GAS float* outf, GAS bf16* outb, const GAS float* g, const GAS float* b) {
    const int gw = F.vcu * NWAVES + F.wave, NGW = F.G * NWAVES;
    for (int m = gw; m < MTOK; m += NGW) {
        const GAS f32x4* xr = (const GAS f32x4*)(in + (size_t)m * DM) + F.lane;
        f32x4 v[8]; float s = 0.f;
#pragma unroll
        for (int j = 0; j < 8; ++j) { v[j] = xr[64 * j]; s += (v[j][0] + v[j][1]) + (v[j][2] + v[j][3]); }
        const float mean = wave_sum(s) * (1.f / DM); float s2 = 0.f;
#pragma unroll
        for (int j = 0; j < 8; ++j) { v[j] = v[j] - mean; s2 += (v[j][0] * v[j][0] + v[j][1] * v[j][1]) + (v[j][2] * v[j][2] + v[j][3] * v[j][3]); }
        const float rstd = 1.f / sqrtf(wave_sum(s2) * (1.f / DM) + 1e-5f);
        GAS f32x4* of = (GAS f32x4*)(outf + (size_t)m * DM) + F.lane; GAS v2u* ob = OUT8 ? (GAS v2u*)((GAS unsigned*)((GAS unsigned char*)outb + (size_t)m * DM) + F.lane) : (GAS v2u*)(outb + (size_t)m * DM) + F.lane;
#pragma unroll
        for (int j = 0; j < 8; ++j) { const f32x4 gg = ((const GAS f32x4*)g)[F.lane + 64 * j], bb = ((const GAS f32x4*)b)[F.lane + 64 * j]; const f32x4 o = v[j] * rstd * gg + bb;
            of[64 * j] = o; if (OUT8) ((GAS unsigned*)ob)[64 * j] = pk4_fp8(o[0], o[1], o[2], o[3]); else ob[64 * j] = (v2u){pk2(o[0], o[1]), pk2(o[2], o[3])}; }
    }
}

#define MFMA32(a, b, c) __builtin_amdgcn_mfma_f32_32x32x16_bf16((a), (b), (c), 0, 0, 0)
#define LADD(p, v) __hip_atomic_fetch_add((p), (v), __ATOMIC_RELAXED, __HIP_MEMORY_SCOPE_WORKGROUP)
namespace at {
constexpr int KSTR = 272, VSTR = 320, KBUF = 64 * KSTR, VBUF = 64 * VSTR;
constexpr int OFF_K0 = 0, OFF_K1 = KBUF, OFF_V0 = 2 * KBUF, OFF_V1 = 2 * KBUF + VBUF, OFF_K2 = 2 * KBUF + 2 * VBUF, OFF_V2 = OFF_K2 + KBUF, OFF_DUMMY = OFF_V2 + VBUF, OFF_MISC = OFF_DUMMY + 1024;
typedef unsigned long long u64;
struct KVRegs { v4u k0, k1, v0, v1; };
DI void kv_load(KVRegs& R, const GAS bf16* Kg, int pk, const GAS bf16* Vg, int pv, int row0, int maxrow, int tid) {
    const int r0 = tid >> 4, ch = tid & 15; int ra = row0 + r0, rb = row0 + r0 + 32; ra = ra > maxrow ? maxrow : ra; rb = rb > maxrow ? maxrow : rb;
    R.k0 = *(const GAS v4u*)(Kg + (size_t)ra * pk + ch * 8); R.k1 = *(const GAS v4u*)(Kg + (size_t)rb * pk + ch * 8);
    R.v0 = *(const GAS v4u*)(Vg + (size_t)ra * pv + ch * 8); R.v1 = *(const GAS v4u*)(Vg + (size_t)rb * pv + ch * 8);
}
DI void kv_store(LAS unsigned char* lds, int kofs, int vofs, const KVRegs& R, int tid) {
    const int r0 = tid >> 4, ch = tid & 15;
    *(LAS v4u*)(lds + kofs + r0 * KSTR + ch * 16) = R.k0; *(LAS v4u*)(lds + kofs + (r0 + 32) * KSTR + ch * 16) = R.k1;
    *(LAS v4u*)(lds + vofs + r0 * VSTR + ch * 16) = R.v0; *(LAS v4u*)(lds + vofs + (r0 + 32) * VSTR + ch * 16) = R.v1;
}
DI u64 range_mask(int lo, int hi) {
    if (hi < 0 || lo > 63 || lo > hi) return 0ull;
    const u64 hm = hi >= 63 ? ~0ull : ((1ull << (hi + 1)) - 1ull);
    const u64 lm = lo <= 0 ? ~0ull : (~0ull << lo);
    return hm & lm;
}
DI s16x4 vtr(LAS const unsigned char* p) { typedef short v4i16_t __attribute__((ext_vector_type(4))); return __builtin_bit_cast(s16x4, __builtin_amdgcn_ds_read_tr16_b64_v4i16((LAS v4i16_t*)p)); }
DI bf16x8 packp(const f32x16& x, int s8) {
    v4u p; p.x = cvtpk(x[s8], x[s8 + 1]); p.y = cvtpk(x[s8 + 2], x[s8 + 3]); p.z = cvtpk(x[s8 + 4], x[s8 + 5]); p.w = cvtpk(x[s8 + 6], x[s8 + 7]);
    return __builtin_bit_cast(bf16x8, p);
}
DI void mask_tile(f32x16& s0, f32x16& s1, u64 allow, int h) {
    const unsigned w0 = (unsigned)allow >> (4 * h), w1 = (unsigned)(allow >> 32) >> (4 * h);
#pragma unroll
    for (int r = 0; r < 16; ++r) { const unsigned bit = 1u << ((r & 3) + 8 * (r >> 2)); if (!(w0 & bit)) s0[r] = -1e30f; if (!(w1 & bit)) s1[r] = -1e30f; }
}
template <bool BIAS> DI void qk_tile(f32x16& s0, f32x16& s1, LAS const unsigned char* kbuf, const bf16x8 (&qf)[8], LAS const float* nbias, int lane, float negm = 0.f) {
    const int r32 = lane & 31, h = lane >> 5;
    if (BIAS) {
#pragma unroll
        for (int g = 0; g < 4; ++g) { const f32x4 b0 = *(LAS const f32x4*)(nbias + 8 * g + 4 * h), b1 = *(LAS const f32x4*)(nbias + 32 + 8 * g + 4 * h);
#pragma unroll
            for (int e = 0; e < 4; ++e) { s0[4 * g + e] = b0[e] + negm; s1[4 * g + e] = b1[e] + negm; } }
    } else {
#pragma unroll
        for (int r = 0; r < 16; ++r) s0[r] = negm;
    }
    LAS const unsigned char* kp = kbuf + r32 * KSTR + h * 16;
#define KFRAG(i) (*(LAS const bf16x8*)(kp + ((i) & 1) * 32 * KSTR + ((i) >> 1) * 32))
    bf16x8 ka[4]; f32x16 s0c = s0;
#pragma unroll
    for (int i = 0; i < 4; ++i) ka[i] = KFRAG(i);
    __builtin_amdgcn_sched_barrier(0);
#pragma unroll
    for (int i = 0; i < 16; ++i) {
        if (i & 1) s1 = MFMA32(ka[i & 3], qf[i >> 1], (!BIAS && i == 1) ? s0c : s1); else { if (!BIAS && i == 0) s0c = s0; s0 = MFMA32(ka[i & 3], qf[i >> 1], s0); }
        if (i + 4 < 16) ka[i & 3] = KFRAG(i + 4);
    }
#undef KFRAG
}
DI void pv_tile(f32x16 (&O)[4], LAS const unsigned char* vbuf, const f32x16& p0, const f32x16& p1, int lane) {
    const int h = lane >> 5;
    LAS const unsigned char* vp = vbuf + (4 * h + ((lane & 15) >> 2)) * VSTR + (16 * ((lane >> 4) & 1) + 4 * (lane & 3)) * 2;
#pragma unroll
    for (int kb = 0; kb < 2; ++kb)
#pragma unroll
        for (int s = 0; s < 2; ++s) {
            const bf16x8 pf = packp(kb ? p1 : p0, 8 * s);
#pragma unroll
            for (int db = 0; db < 4; ++db) {
                const s16x4 lo = vtr(vp + (kb * 32 + 16 * s) * VSTR + db * 64), hi = vtr(vp + (kb * 32 + 16 * s + 8) * VSTR + db * 64);
                const bf16x8 vf = __builtin_shufflevector(lo, hi, 0, 1, 2, 3, 4, 5, 6, 7);
                O[db] = MFMA32(vf, pf, O[db]);
            }
        }
}
template <bool BIAS> DI void attn_tile(LAS const unsigned char* kbuf, LAS const unsigned char* vbuf, const bf16x8 (&qf)[8], f32x16 (&O)[4], float& m, float& l, u64 allow, LAS const float* nbias, int lane) {
    const int h = lane >> 5;
    f32x16 s0, s1;
    qk_tile<BIAS>(s0, s1, kbuf, qf, nbias, lane, -m);
    if (!__all(allow == ~0ull)) mask_tile(s0, s1, allow, h);
    float mx = fmaxf(fmaxf(s0[0], s1[0]), fmaxf(s0[1], s1[1]));
#pragma unroll
    for (int r = 2; r < 16; r += 2) mx = fmaxf(mx, fmaxf(fmaxf(s0[r], s1[r]), fmaxf(s0[r + 1], s1[r + 1])));
    mx = fmaxf(mx, __shfl_xor(mx, 32));
    if (__any(mx > 8.0f)) {
        const float dl = fmaxf(mx, 0.f), alpha = ex2(-dl); l *= alpha; m += dl;
#pragma unroll
        for (int r = 0; r < 16; ++r) { s0[r] -= dl; s1[r] -= dl; }
#pragma unroll
        for (int d = 0; d < 4; ++d)
#pragma unroll
            for (int r = 0; r < 16; ++r) O[d][r] *= alpha;
    }
    float sum = 0.f;
#pragma unroll
    for (int r = 0; r < 16; ++r) { s0[r] = ex2(s0[r]); sum += s0[r]; }
    {
        const int h = lane >> 5;
        LAS const unsigned char* vp = vbuf + (4 * h + ((lane & 15) >> 2)) * VSTR + (16 * ((lane >> 4) & 1) + 4 * (lane & 3)) * 2;
#pragma unroll
        for (int kb = 0; kb < 2; ++kb)
#pragma unroll
            for (int s = 0; s < 2; ++s) {
                const bf16x8 pf = packp(kb ? s1 : s0, 8 * s);
#pragma unroll
                for (int db = 0; db < 4; ++db) {
                    const s16x4 lo = vtr(vp + (kb * 32 + 16 * s) * VSTR + db * 64), hi = vtr(vp + (kb * 32 + 16 * s + 8) * VSTR + db * 64);
                    const bf16x8 vf = __builtin_shufflevector(lo, hi, 0, 1, 2, 3, 4, 5, 6, 7);
                    O[db] = MFMA32(vf, pf, O[db]);
                    if (kb == 0) { const int r = 2 * (4 * s + db); s1[r] = ex2(s1[r]); s1[r + 1] = ex2(s1[r + 1]); sum += s1[r] + s1[r + 1]; }
                }
            }
    }
    l += sum;
}
DI void glds16(const GAS void* gsrc, unsigned lds_dst) { unsigned keep;
    asm volatile("s_mov_b32 %0, m0\n\ts_mov_b32 m0, %2\n\ts_nop 0\n\tglobal_load_lds_dwordx4 %1, off\n\ts_mov_b32 m0, %0" : "=&s"(keep) : "v"(gsrc), "s"(lds_dst) : "memory"); }
template <bool BIAS, bool D2, class AllowF> DI void attn_pass(LAS unsigned char* lds, const GAS bf16* Kg, int pk, const GAS bf16* Vg, int pv, int maxrow, unsigned tset,
                                                       const bf16x8 (&qf)[8], f32x16 (&O)[4], float& m, float& l, const AllowF& allowf, LAS const float* nbias, int tid, int lane) {
    if (tset == 0u) return;
    const int wave = __builtin_amdgcn_readfirstlane(tid >> 6);
    const unsigned lds0 = (unsigned)(size_t)lds;
    unsigned doff[5];
#pragma unroll
    for (int k = 0; k < 5; ++k) { const int q = wave + 8 * k;
        if (q < 17) { const int c = 64 * q + lane, r = c / 17, col = c - 17 * r; doff[k] = (unsigned)(r * pk * 2 + (col < 16 ? col : 15) * 16); }
        else if (q < 37) { const int c = 64 * (q - 17) + lane, r = c / 20, col = c - 20 * r; doff[k] = (unsigned)(r * pv * 2 + (col < 16 ? col : 15) * 16); }
        else doff[k] = (unsigned)((lane & 15) * 16); }
#define ISSUE_TILE(jt, slot) do { const GAS unsigned char* kb_ = (const GAS unsigned char*)(Kg + (size_t)(64 * (jt)) * pk); const GAS unsigned char* vb_ = (const GAS unsigned char*)(Vg + (size_t)(64 * (jt)) * pv); \
        const unsigned ko_ = lds0 + ((slot) == 0 ? OFF_K0 : (slot) == 1 ? OFF_K1 : OFF_K2), vo_ = lds0 + ((slot) == 0 ? OFF_V0 : (slot) == 1 ? OFF_V1 : OFF_V2); \
        _Pragma("unroll") for (int k = 0; k < 5; ++k) { const int q = wave + 8 * k; \
            if (q < 17) glds16(kb_ + doff[k], (unsigned)__builtin_amdgcn_readfirstlane(ko_ + 1024 * q)); \
            else if (q < 37) glds16(vb_ + doff[k], (unsigned)__builtin_amdgcn_readfirstlane(vo_ + 1024 * (q - 17))); \
            else glds16(kb_ + doff[k], (unsigned)__builtin_amdgcn_readfirstlane(lds0 + OFF_DUMMY)); } } while (0)
    int j = __builtin_ctz(tset); tset &= tset - 1u;
    u64 raw = allowf.pre(j);
    ISSUE_TILE(j, 0);
    bool more = tset != 0u; int jn = 0; u64 rawn = 0ull;
    if (more) { jn = __builtin_ctz(tset); tset &= tset - 1u; rawn = allowf.pre(jn); ISSUE_TILE(jn, 1); asm volatile("s_waitcnt vmcnt(5)\n\ts_barrier" ::: "memory"); }
    else asm volatile("s_waitcnt vmcnt(0)\n\ts_barrier" ::: "memory");
    int s0 = 0, s1 = 1, s2 = 2;
    for (;;) {
        const bool more2 = more && tset != 0u; int jn2 = 0; u64 rawn2 = 0ull;
        if (more2) { jn2 = __builtin_ctz(tset); tset &= tset - 1u; rawn2 = allowf.pre(jn2); ISSUE_TILE(jn2, s2); }
        const u64 allow = allowf.make(j, raw);
        if (__any(allow != 0ull)) attn_tile<BIAS>(lds + (s0 == 0 ? OFF_K0 : s0 == 1 ? OFF_K1 : OFF_K2), lds + (s0 == 0 ? OFF_V0 : s0 == 1 ? OFF_V1 : OFF_V2), qf, O, m, l, allow, nbias + 64 * j, lane);
        if (more2) asm volatile("s_waitcnt vmcnt(5) lgkmcnt(0)\n\ts_barrier" ::: "memory");
        else asm volatile("s_waitcnt vmcnt(0) lgkmcnt(0)\n\ts_barrier" ::: "memory");
        if (!more) break;
        j = jn; raw = rawn; jn = jn2; rawn = rawn2; more = more2;
        const int t_ = s0; s0 = s1; s1 = s2; s2 = t_;
    }
#undef ISSUE_TILE
}
DI unsigned tile_range(int j0, int j1) {
    if (j1 <= j0) return 0u;
    const unsigned hi = j1 >= 32 ? ~0u : ((1u << j1) - 1u); return hi & ~((1u << j0) - 1u);
}
DI void load_q(bf16x8 (&qf)[8], const GAS bf16* Qrow, int lane) {
#pragma unroll
    for (int ks = 0; ks < 8; ++ks) qf[ks] = *(const GAS bf16x8*)(Qrow + ks * 16 + (lane >> 5) * 8);
}
DI void store_o(GAS bf16* Orow, const f32x16 (&O)[4], float sc, int lane) {
    const int h = lane >> 5;
#pragma unroll
    for (int db = 0; db < 4; ++db)
#pragma unroll
        for (int g = 0; g < 4; ++g) { v2u w; w.x = cvtpk(O[db][4 * g] * sc, O[db][4 * g + 1] * sc); w.y = cvtpk(O[db][4 * g + 2] * sc, O[db][4 * g + 3] * sc);
            *(GAS v2u*)(Orow + 32 * db + 8 * g + 4 * h) = w; }
}
struct AllowCausal { int q; DI u64 pre(int) const { return 0ull; } DI u64 make(int j, u64) const { return range_mask(0, q - 64 * j); } DI u64 rng(int j) const { return range_mask(0, q - 64 * j); } };
struct AllowWin { int q; DI u64 pre(int) const { return 0ull; } DI u64 make(int j, u64) const { return range_mask(q - 511 - 64 * j, q - 64 * j); } DI u64 rng(int j) const { return range_mask(q - 511 - 64 * j, q - 64 * j); } };
struct AllowSlc { int q; unsigned sel; DI u64 pre(int) const { return 0ull; } DI u64 make(int j, u64) const { return ((sel >> j) & 1u) ? range_mask(0, q - 64 * j) : 0ull; } DI u64 rng(int j) const { return ((sel >> j) & 1u) ? range_mask(0, q - 64 * j) : 0ull; } };
struct AllowDsa { int q; const GAS u64* bm; DI u64 pre(int j) const { return bm[j]; } DI u64 make(int j, u64 raw) const { return raw & range_mask(0, q - 64 * j); } DI u64 rng(int j) const { return range_mask(0, q - 64 * j); } };
}

DI void fox_unit(Frame& F, const GAS float* fbias_l, int b, int hd, int qb) {
    using namespace at;
    LAS unsigned char* lds = F.lds; const int tid = F.tid, lane = F.lane, wave = F.wave;
    LAS float* ncum = (LAS float*)(lds + OFF_MISC);
    LAS float* wtot = (LAS float*)(lds + OFF_MISC + 8192);
    const GAS float* SM = (const GAS float*)(F.ws + A_SM);
    const int n = 256 * (qb + 1);
    {
        const float fb = fbias_l[hd]; float v[4]; float run = 0.f;
#pragma unroll
        for (int e = 0; e < 4; ++e) { const int t = tid * 4 + e; float ls = 0.f;
            if (t < n) { const float x = SM[(size_t)(b * SEQ + t) * 64 + hd] + fb; ls = fminf(x, 0.f) - __logf(1.0f + __expf(-fabsf(x))); }
            run += ls; v[e] = run; }
        float inc = run;
#pragma unroll
        for (int o = 1; o < 64; o <<= 1) { const float t = __shfl_up(inc, o); if (lane >= o) inc += t; }
        if (lane == 63) wtot[wave] = inc;
        __syncthreads();
        float base = inc - run;
        for (int w = 0; w < wave; ++w) base += wtot[w];
#pragma unroll
        for (int e = 0; e < 4; ++e) ncum[tid * 4 + e] = -(base + v[e]) * 1.4426950408889634f;
        __syncthreads();
    }
    const int q0 = 256 * qb + 32 * wave, q = q0 + (lane & 31); const size_t qrow = (size_t)b * SEQ + q;
    bf16x8 qf[8]; load_q(qf, (const GAS bf16*)(F.ws + A_FQ) + qrow * 768 + hd * 128, lane);
    f32x16 O[4];
#pragma unroll
    for (int d = 0; d < 4; ++d)
#pragma unroll
        for (int r = 0; r < 16; ++r) O[d][r] = 0.f;
    float m = 0.f, l = 0.f;
    const GAS bf16* Kg = (const GAS bf16*)(F.ws + A_FK) + (size_t)b * SEQ * 768 + hd * 128; const GAS bf16* Vg = (const GAS bf16*)(F.ws + A_FV) + (size_t)b * SEQ * 768 + hd * 128;
    attn_pass<true, true>(lds, Kg, 768, Vg, 768, SEQ - 1, tile_range(0, 4 * (qb + 1)), qf, O, m, l, AllowCausal{q}, ncum, tid, lane);
    const float lt = l + __shfl_xor(l, 32);
    store_o((GAS bf16*)(F.ws + A_OF) + qrow * 768 + hd * 128, O, lt > 0.f ? 1.0f / lt : 0.f, lane);
}

DI void indexer_unit(Frame& F, int b, int qb, int kb) {
    LAS unsigned char* lds = F.lds; const int tid = F.tid, lane = F.lane, wave = F.wave, r32 = lane & 31, h = lane >> 5;
    constexpr int ISTR = 144;
    {
        const GAS bf16* IK = (const GAS bf16*)(F.ws + A_IK) + ((size_t)b * SEQ + 256 * kb) * 64;
#pragma unroll
        for (int i = 0; i < 4; ++i) { const int idx = tid + 512 * i, row = idx >> 3, ch = idx & 7; *(LAS v4u*)(lds + row * ISTR + ch * 16) = *(const v4u*)(IK + (size_t)row * 64 + ch * 8); }
    }
    __syncthreads();
    const int q0 = 256 * qb + 32 * wave, q = q0 + r32; const size_t qrow = (size_t)b * SEQ + q;
    const int nblk = (kb < qb) ? 8 : (wave + 1);
    const GAS bf16* IQ = (const GAS bf16*)(F.ws + A_IQ) + qrow * 1024 + h * 8; const GAS float* wq = (const GAS float*)(F.ws + A_SM) + qrow * 64 + 18;
    GAS float* SC = (GAS float*)(F.ws + A_SC) + qrow * SEQ + 256 * kb + 4 * h;
    for (int kh = 0; kh < 2; ++kh) {
        if (4 * kh >= nblk) break;
        f32x16 acc[4];
#pragma unroll
        for (int k = 0; k < 4; ++k)
#pragma unroll
            for (int r = 0; r < 16; ++r) acc[k][r] = 0.f;
        bf16x8 kf[4][4];
#pragma unroll
        for (int k = 0; k < 4; ++k)
#pragma unroll
            for (int ks = 0; ks < 4; ++ks) kf[k][ks] = *(LAS const bf16x8*)(lds + (128 * kh + 32 * k + r32) * ISTR + h * 16 + ks * 32);
        bf16x8 qf[4], qn[4]; float w, wn;
#pragma unroll
        for (int ks = 0; ks < 4; ++ks) qf[ks] = *(const bf16x8*)(IQ + ks * 16);
        w = wq[0] * 0.03125f;
        for (int hd = 0; hd < 16; ++hd) {
            const int hn = hd < 15 ? hd + 1 : 15;
#pragma unroll
            for (int ks = 0; ks < 4; ++ks) qn[ks] = *(const bf16x8*)(IQ + hn * 64 + ks * 16);
            wn = wq[hn] * 0.03125f;
#pragma unroll
            for (int k = 0; k < 4; ++k) {
                if (4 * kh + k < nblk) {
                    f32x16 s = {};
#pragma unroll
                    for (int ks = 0; ks < 4; ++ks) s = MFMA32(kf[k][ks], qf[ks], s);
#pragma unroll
                    for (int r = 0; r < 16; ++r) acc[k][r] += w * fmaxf(s[r], 0.f);
                }
            }
#pragma unroll
            for (int ks = 0; ks < 4; ++ks) qf[ks] = qn[ks];
            w = wn;
        }
#pragma unroll
        for (int k = 0; k < 4; ++k)
            if (4 * kh + k < nblk) {
#pragma unroll
                for (int g = 0; g < 4; ++g) *(f32x4*)(SC + 128 * kh + 32 * k + 8 * g) = (f32x4){acc[k][4 * g], acc[k][4 * g + 1], acc[k][4 * g + 2], acc[k][4 * g + 3]};
            }
    }
    __syncthreads();
}

DI void kvup_unit(Frame& F, const GAS bf16* Wt, int u) {
    const int lane = F.lane, wave = F.wave, r32 = lane & 31, h = lane >> 5;
    bf16x8 af[16];
    const GAS bf16* wrow = Wt + (size_t)(32 * wave + r32) * 256 + h * 8;
#pragma unroll
    for (int ks = 0; ks < 16; ++ks) af[ks] = *(const bf16x8*)(wrow + ks * 16);
    const GAS f32x2* rope = (const GAS f32x2*)(F.ws + WS_ROPE128);
    for (int tb = 0; tb < 4; ++tb) {
        const int m = 128 * u + 32 * tb + r32; const GAS bf16* xr = (const GAS bf16*)(F.ws + A_CKV) + (size_t)m * 256 + h * 8;
        f32x16 d; float ss = 0.f;
#pragma unroll
        for (int r = 0; r < 16; ++r) d[r] = 0.f;
#pragma unroll
        for (int ks = 0; ks < 16; ++ks) { const bf16x8 bfr = *(const bf16x8*)(xr + ks * 16); const v4u w = __builtin_bit_cast(v4u, bfr);
            ss += bfl(w.x) * bfl(w.x) + bfh(w.x) * bfh(w.x) + bfl(w.y) * bfl(w.y) + bfh(w.y) * bfh(w.y) + bfl(w.z) * bfl(w.z) + bfh(w.z) * bfh(w.z) + bfl(w.w) * bfl(w.w) + bfh(w.w) * bfh(w.w);
            d = MFMA32(af[ks], bfr, d); }
        ss += __shfl_xor(ss, 32);
        const float rstd = 1.0f / sqrtf(ss * (1.0f / 256.0f) + 1e-6f);
        const int pos = m & (SEQ - 1);
        GAS bf16* dst = (wave < 4) ? (GAS bf16*)(F.ws + A_KD) + (size_t)m * 128 + 32 * wave : (GAS bf16*)(F.ws + A_VD) + (size_t)m * 128 + 32 * (wave - 4);
#pragma unroll
        for (int g = 0; g < 4; ++g) {
            float v0 = d[4 * g] * rstd, v1 = d[4 * g + 1] * rstd, v2 = d[4 * g + 2] * rstd, v3 = d[4 * g + 3] * rstd;
            if (wave < 4) { const f32x4 cs = *(const f32x4*)(rope + (size_t)pos * 64 + 16 * wave + 4 * g + 2 * h);
                const float a0 = v0 * cs[0] - v1 * cs[1], a1 = v0 * cs[1] + v1 * cs[0], a2 = v2 * cs[2] - v3 * cs[3], a3 = v2 * cs[3] + v3 * cs[2]; v0 = a0; v1 = a1; v2 = a2; v3 = a3; }
            *(v2u*)(dst + 8 * g + 4 * h) = (v2u){cvtpk(v0, v1), cvtpk(v2, v3)};
        }
    }
}

DI void compress1_unit(Frame& F, const GAS unsigned char* wl, int l, int u) {
    const int lane = F.lane, wave = F.wave, r32 = lane & 31, h = lane >> 5;
    const int kv = u >> 5, rb = (u >> 1) & 15, chh = u & 1, R0 = 32 * rb, n0 = 128 * chh + 32 * (wave & 3), kh = wave >> 2;
    const int mrow = R0 + r32, bb = mrow >> 7, c = mrow & 127;
    const GAS bf16* ar = (const GAS bf16*)(F.ws + (kv ? A_VC : A_KC)) + ((size_t)bb * SEQ + 16 * c) * 128 + 2048 * kh + h * 8;
    const GAS bf16* br = (const GAS bf16*)(wl + (kv ? WO_CV1 : WO_CK1)) + (size_t)(n0 + r32) * 4096 + 2048 * kh + h * 8;
    f32x16 d;
#pragma unroll
    for (int r = 0; r < 16; ++r) d[r] = 0.f;
    for (int k0 = 0; k0 < 2048; k0 += 128) {
        bf16x8 a[8], bq[8];
#pragma unroll
        for (int i = 0; i < 8; ++i) { a[i] = *(const GAS bf16x8*)(ar + k0 + 16 * i); bq[i] = *(const GAS bf16x8*)(br + k0 + 16 * i); }
#pragma unroll
        for (int i = 0; i < 8; ++i) d = MFMA32(a[i], bq[i], d);
    }
    LAS float* xch = (LAS float*)F.lds + (wave & 3) * 1024;
    if (kh == 1) {
#pragma unroll
        for (int r = 0; r < 16; ++r) xch[r * 64 + lane] = d[r];
    }
    __syncthreads();
    if (kh == 0) {
        float bias = 0.f; { const GAS float* cbp = (const GAS float*)(F.ws + A_CBP) + (size_t)(l * 2 + kv) * 32 * 256 + n0 + r32;
#pragma unroll 8
            for (int kc = 0; kc < 32; ++kc) bias += cbp[kc * 256]; }
        GAS bf16* HC = (GAS bf16*)(F.ws + A_HC) + (size_t)kv * 512 * 256 + n0 + r32;
#pragma unroll
        for (int r = 0; r < 16; ++r) {
            const int row = R0 + (r & 3) + 8 * (r >> 2) + 4 * h; const float x = d[r] + xch[r * 64 + lane] + bias;
            const float t = 0.7978845608028654f * (x + 0.044715f * x * x * x); const float th = 1.0f - 2.0f * __builtin_amdgcn_rcpf(1.0f + __expf(2.0f * t));
            HC[(size_t)row * 256] = (bf16)f2bf(0.5f * x * (1.0f + th));
        }
    }
    __syncthreads();
}
DI void compress2_unit(Frame& F, const GAS unsigned char* wl, int u) {
    const int lane = F.lane, wave = F.wave, r32 = lane & 31, h = lane >> 5;
    const int kv = u >> 3, wb = (u & 7) * 8 + wave, cblk = wb >> 2, nblk = wb & 3;
    const GAS bf16* ar = (const GAS bf16*)(wl + (kv ? WO_CV2 : WO_CK2)) + (size_t)(32 * nblk + r32) * 256 + h * 8;
    const int row = 32 * cblk + r32;
    const GAS bf16* br = (const GAS bf16*)(F.ws + A_HC) + ((size_t)kv * 512 + row) * 256 + h * 8;
    f32x16 d;
#pragma unroll
    for (int r = 0; r < 16; ++r) d[r] = 0.f;
#pragma unroll
    for (int ks = 0; ks < 16; ++ks) d = MFMA32(*(const bf16x8*)(ar + ks * 16), *(const bf16x8*)(br + ks * 16), d);
    const int c = row & 127; int pos = 16 * c + 31; pos = pos > SEQ - 1 ? SEQ - 1 : pos;
    const GAS f32x2* rope = (const GAS f32x2*)(F.ws + WS_ROPE128);
    GAS bf16* dst = (GAS bf16*)(F.ws + (kv ? A_VCMP : A_KCMP)) + (size_t)row * 128 + 32 * nblk;
#pragma unroll
    for (int g = 0; g < 4; ++g) {
        float v0 = d[4 * g], v1 = d[4 * g + 1], v2 = d[4 * g + 2], v3 = d[4 * g + 3];
        if (kv == 0) { const f32x4 cs = *(const f32x4*)(rope + (size_t)pos * 64 + 16 * nblk + 4 * g + 2 * h);
            const float a0 = v0 * cs[0] - v1 * cs[1], a1 = v0 * cs[1] + v1 * cs[0], a2 = v2 * cs[2] - v3 * cs[3], a3 = v2 * cs[3] + v3 * cs[2]; v0 = a0; v1 = a1; v2 = a2; v3 = a3; }
        *(v2u*)(dst + 8 * g + 4 * h) = (v2u){cvtpk(v0, v1), cvtpk(v2, v3)};
    }
}

DI void sel_load(unsigned (&v)[32], const GAS float* sc, int t, int lane) {
    const int ntl = (t >> 6) + 1;
#pragma unroll
    for (int i = 0; i < 32; ++i) {
        unsigned key = 0u;
        if (i < ntl) { const int kx = 64 * i + lane; if (kx <= t) { const unsigned fb = __float_as_uint(sc[kx]); key = (fb & 0x80000000u) ? ~fb : (fb | 0x80000000u); } }
        v[i] = key;
    }
}
template <int NR> DI int wave_count_ge(const unsigned (&v)[32], unsigned cand) {
    int tot = 0;
#pragma unroll
    for (int i = 0; i < NR; ++i) tot += __builtin_popcountll(__ballot(v[i] >= cand));
    return tot;
}
template <int NR> DI unsigned sel_threshold(const unsigned (&v)[32]) {
    unsigned kmax = v[0];
#pragma unroll
    for (int i = 1; i < NR; ++i) kmax = v[i] > kmax ? v[i] : kmax;
#pragma unroll
    for (int o = 1; o < 64; o <<= 1) { const unsigned x = (unsigned)__shfl_xor((int)kmax, o); kmax = x > kmax ? x : kmax; }
    unsigned T = 0u; int bit0 = 31; bool done = false;
    {
        unsigned P = kmax & 0xFF800000u;
        for (int d = 0; d < 8 && P >= 0x80800000u; ++d, P -= 0x00800000u) {
            const int cnt = wave_count_ge<NR>(v, P);
            if (cnt >= 256) { T = P; bit0 = 22; done = (cnt == 256); break; }
        }
    }
    if (!done)
        for (int bit = bit0; bit >= 0; --bit) {
            const unsigned cand = T | (1u << bit); const int cnt = wave_count_ge<NR>(v, cand);
            if (cnt >= 256) { T = cand; if (cnt == 256) break; }
        }
    return T;
}
DI void sel_row(const unsigned (&v)[32], GAS unsigned long long* bm, int t, int lane) {
    typedef unsigned long long u64;
    if (t < 256) { if (lane < 32) bm[lane] = ~0ull; return; }
    const int ntl = (t >> 6) + 1;
    const unsigned T = ntl <= 8 ? sel_threshold<8>(v) : ntl <= 16 ? sel_threshold<16>(v) : ntl <= 24 ? sel_threshold<24>(v) : sel_threshold<32>(v);
    u64 mine = 0ull;
#pragma unroll
    for (int i = 0; i < 32; ++i) { const u64 bal = __ballot(v[i] >= T); if (lane == i) mine = bal; }
    if (lane < 32) bm[lane] = mine;
}
DI void dsa_select_unit(Frame& F, int u) {
    const int lane = F.lane, wave = F.wave;
    {
    const int m0 = 32 * u + 4 * wave, t0 = m0 & (SEQ - 1);
    const GAS float* sc = (const GAS float*)(F.ws + A_SC) + (size_t)m0 * SEQ; GAS unsigned long long* bm = (GAS unsigned long long*)(F.ws + A_BM) + (size_t)m0 * 32;
    unsigned va[32], vb[32];
    if (t0 >= 256) { sel_load(va, sc, t0, lane); sel_load(vb, sc + SEQ, t0 + 1, lane); }
    sel_row(va, bm, t0, lane);
    if (t0 >= 256) sel_load(va, sc + 2 * SEQ, t0 + 2, lane);
    sel_row(vb, bm + 32, t0 + 1, lane);
    if (t0 >= 256) sel_load(vb, sc + 3 * SEQ, t0 + 3, lane);
    sel_row(va, bm + 64, t0 + 2, lane);
    sel_row(vb, bm + 96, t0 + 3, lane);
    }
}

DI void dsa_attn_unit(Frame& F, int b, int u) {
    using namespace at;
    LAS unsigned char* lds = F.lds; const int tid = F.tid, lane = F.lane, wave = F.wave;
    const int t = 8 * u + wave, qblk = t / 6, hd = t - 6 * qblk, q = 32 * qblk + (lane & 31); const size_t qrow = (size_t)b * SEQ + q;
    bf16x8 qf[8]; load_q(qf, (const GAS bf16*)(F.ws + A_DQ) + qrow * 768 + hd * 128, lane);
    f32x16 O[4];
#pragma unroll
    for (int d = 0; d < 4; ++d)
#pragma unroll
        for (int r = 0; r < 16; ++r) O[d][r] = 0.f;
    float m = 0.f, l = 0.f;
    const int lastq = 32 * ((8 * u + 7) / 6) + 31;
    const GAS bf16* Kg = (const GAS bf16*)(F.ws + A_KD) + (size_t)b * SEQ * 128; const GAS bf16* Vg = (const GAS bf16*)(F.ws + A_VD) + (size_t)b * SEQ * 128;
    attn_pass<false, true>(lds, Kg, 128, Vg, 128, SEQ - 1, tile_range(0, (lastq >> 6) + 1), qf, O, m, l, AllowDsa{q, (const GAS u64*)(F.ws + A_BM) + qrow * 32}, (LAS const float*)nullptr, tid, lane);
    const float lt = l + __shfl_xor(l, 32);
    store_o((GAS bf16*)(F.ws + A_OD) + qrow * 768 + hd * 128, O, lt > 0.f ? 1.0f / lt : 0.f, lane);
}

DI void nsa_unit(Frame& F, int b, int qb) {
    using namespace at;
    LAS unsigned char* lds = F.lds; const int tid = F.tid, lane = F.lane, wave = F.wave, r32 = lane & 31, h = lane >> 5;
    LAS float* imp = (LAS float*)(lds + OFF_K2);
    LAS unsigned* selm = (LAS unsigned*)(lds + OFF_K2 + 8 * 32 * 33 * 4);
    const int hd = wave & 3, qs = wave >> 2, ql = 32 * qs + r32, q = 64 * qb + ql; const size_t qrow = (size_t)b * SEQ + q;
    for (int i = tid; i < 8 * 32 * 33 + 65; i += 512) imp[i] = 0.f;
    bf16x8 qf[8]; load_q(qf, (const GAS bf16*)(F.ws + A_NQ) + qrow * 512 + hd * 128, lane);
    const GAS float* gl = (const GAS float*)(F.ws + A_SM) + qrow * 64 + 6 + 3 * hd;
    const float g0 = sigm(gl[0]), g1 = sigm(gl[1]), g2 = sigm(gl[2]);
    GAS float* ocs = (GAS float*)(F.ws + A_OCS) + qrow * 512 + hd * 128 + 4 * h;
    {
        KVRegs R; const GAS bf16* Kg = (const GAS bf16*)(F.ws + A_KCMP) + (size_t)b * 128 * 128; const GAS bf16* Vg = (const GAS bf16*)(F.ws + A_VCMP) + (size_t)b * 128 * 128;
        kv_load(R, Kg, 128, Vg, 128, 0, 127, tid); kv_store(lds, OFF_K0, OFF_V0, R, tid);
        kv_load(R, Kg, 128, Vg, 128, 64, 127, tid); kv_store(lds, OFF_K1, OFF_V1, R, tid);
        __syncthreads();
        f32x16 s0, s1, s2, s3;
        qk_tile<false>(s0, s1, lds + OFF_K0, qf, (LAS const float*)nullptr, lane);
        qk_tile<false>(s2, s3, lds + OFF_K1, qf, (LAS const float*)nullptr, lane);
        const int cmax = (q - 31) >> 4;
        mask_tile(s0, s1, range_mask(0, cmax), h); mask_tile(s2, s3, range_mask(0, cmax - 64), h);
        float mx = -1e25f;
#pragma unroll
        for (int r = 0; r < 16; ++r) mx = fmaxf(mx, fmaxf(fmaxf(s0[r], s1[r]), fmaxf(s2[r], s3[r])));
        mx = fmaxf(mx, __shfl_xor(mx, 32));
        float sum = 0.f;
#pragma unroll
        for (int r = 0; r < 16; ++r) { s0[r] = ex2(s0[r] - mx); s1[r] = ex2(s1[r] - mx); s2[r] = ex2(s2[r] - mx); s3[r] = ex2(s3[r] - mx); sum += (s0[r] + s1[r]) + (s2[r] + s3[r]); }
        sum += __shfl_xor(sum, 32);
        const float inv = sum > 0.f ? 1.0f / sum : 0.f;
#pragma unroll
        for (int r = 0; r < 16; ++r) { s0[r] *= inv; s1[r] *= inv; s2[r] *= inv; s3[r] *= inv; }
#pragma unroll
        for (int g = 0; g < 4; ++g) {
            LAS float* ip = imp + (wave * 32 + r32) * 33 + 2 * g + h;
            LADD(ip, s0[4 * g] + s0[4 * g + 1] + s0[4 * g + 2] + 0.5f * s0[4 * g + 3]); LADD(ip + 1, 0.5f * s0[4 * g + 3]);
            LADD(ip + 8, s1[4 * g] + s1[4 * g + 1] + s1[4 * g + 2] + 0.5f * s1[4 * g + 3]); LADD(ip + 9, 0.5f * s1[4 * g + 3]);
            LADD(ip + 16, s2[4 * g] + s2[4 * g + 1] + s2[4 * g + 2] + 0.5f * s2[4 * g + 3]); LADD(ip + 17, 0.5f * s2[4 * g + 3]);
            LADD(ip + 24, s3[4 * g] + s3[4 * g + 1] + s3[4 * g + 2] + 0.5f * s3[4 * g + 3]); if (2 * g + h + 25 < 33) LADD(ip + 25, 0.5f * s3[4 * g + 3]);
        }
        f32x16 O[4];
#pragma unroll
        for (int d = 0; d < 4; ++d)
#pragma unroll
            for (int r = 0; r < 16; ++r) O[d][r] = 0.f;
        pv_tile(O, lds + OFF_V0, s0, s1, lane); pv_tile(O, lds + OFF_V1, s2, s3, lane);
#pragma unroll
        for (int d = 0; d < 4; ++d)
#pragma unroll
            for (int g = 0; g < 4; ++g) *(f32x4*)(ocs + 32 * d + 8 * g) = (f32x4){g0 * O[d][4 * g], g0 * O[d][4 * g + 1], g0 * O[d][4 * g + 2], g0 * O[d][4 * g + 3]};
    }
    __syncthreads();
    {
        const int qq = tid >> 3, sub = tid & 7, qpos = 64 * qb + qq, cur = qpos >> 6;
        float val[32];
#pragma unroll
        for (int j = 0; j < 32; ++j) { const bool forced = (j == 0) | (j == cur) | (j == cur - 1); const LAS float* ib = imp + ((qq >> 5) * 4 * 32 + (qq & 31)) * 33 + j; const float iv = ((ib[0] + ib[32 * 33]) + ib[2 * 32 * 33]) + ib[3 * 32 * 33];
            val[j] = forced ? 1e4f : (j <= cur ? iv : -1e4f); }
        unsigned bits = 0u;
#pragma unroll
        for (int jj = 0; jj < 4; ++jj) {
            int rank = 0; float mine = 0.f; const int j = 4 * sub + jj;
#pragma unroll
            for (int i = 0; i < 32; ++i) mine = (i == j) ? val[i] : mine;
#pragma unroll
            for (int i = 0; i < 32; ++i) rank += (val[i] > mine || (val[i] == mine && i < j)) ? 1 : 0;
            if (rank < 16) bits |= 1u << j;
        }
        bits |= __shfl_xor(bits, 1); bits |= __shfl_xor(bits, 2); bits |= __shfl_xor(bits, 4);
        __syncthreads();
        if (sub == 0) { selm[qq] = bits; __hip_atomic_fetch_or(&selm[64], bits, __ATOMIC_RELAXED, __HIP_MEMORY_SCOPE_WORKGROUP); }
    }
    __syncthreads();
    const unsigned sel = selm[ql], tset_slc = selm[64] & tile_range(0, qb + 1);
    {
        f32x16 O[4];
#pragma unroll
        for (int d = 0; d < 4; ++d)
#pragma unroll
            for (int r = 0; r < 16; ++r) O[d][r] = 0.f;
        float m = 0.f, l = 0.f;
        const GAS bf16* Kg = (const GAS bf16*)(F.ws + A_KS) + (size_t)b * SEQ * 128; const GAS bf16* Vg = (const GAS bf16*)(F.ws + A_VS) + (size_t)b * SEQ * 128;
        attn_pass<false, false>(lds, Kg, 128, Vg, 128, SEQ - 1, tset_slc, qf, O, m, l, AllowSlc{q, sel}, (LAS const float*)nullptr, tid, lane);
        const float lt = l + __shfl_xor(l, 32), sc = lt > 0.f ? g1 / lt : 0.f;
#pragma unroll
        for (int d = 0; d < 4; ++d)
#pragma unroll
            for (int g = 0; g < 4; ++g) { f32x4 t = *(const f32x4*)(ocs + 32 * d + 8 * g); t[0] += sc * O[d][4 * g]; t[1] += sc * O[d][4 * g + 1]; t[2] += sc * O[d][4 * g + 2]; t[3] += sc * O[d][4 * g + 3]; *(f32x4*)(ocs + 32 * d + 8 * g) = t; }
    }
    {
        f32x16 O[4];
#pragma unroll
        for (int d = 0; d < 4; ++d)
#pragma unroll
            for (int r = 0; r < 16; ++r) O[d][r] = 0.f;
        float m = 0.f, l = 0.f;
        const GAS bf16* Kg = (const GAS bf16*)(F.ws + A_KW) + (size_t)b * SEQ * 128; const GAS bf16* Vg = (const GAS bf16*)(F.ws + A_VW) + (size_t)b * SEQ * 128;
        const int j0 = qb - 8 < 0 ? 0 : qb - 8;
        attn_pass<false, false>(lds, Kg, 128, Vg, 128, SEQ - 1, tile_range(j0, qb + 1), qf, O, m, l, AllowWin{q}, (LAS const float*)nullptr, tid, lane);
        const float lt = l + __shfl_xor(l, 32), sc = lt > 0.f ? g2 / lt : 0.f;
        GAS bf16* orow = (GAS bf16*)(F.ws + A_ON) + qrow * 768 + hd * 128 + 4 * h;
#pragma unroll
        for (int d = 0; d < 4; ++d)
#pragma unroll
            for (int g = 0; g < 4; ++g) { const f32x4 t = *(const f32x4*)(ocs + 32 * d + 8 * g);
                *(v2u*)(orow + 32 * d + 8 * g) = (v2u){cvtpk(t[0] + sc * O[d][4 * g], t[1] + sc * O[d][4 * g + 1]), cvtpk(t[2] + sc * O[d][4 * g + 2], t[3] + sc * O[d][4 * g + 3])}; }
    }
}
DI GAS unsigned char* launder(GAS unsigned char* p) { asm volatile("" : "+s"(p)); return p; }
DI int launder_i(int v) { asm volatile("" : "+s"(v)); return v; }
#ifndef UDUP
#define UDUP 0
#endif
#ifndef DUPM
#define DUPM 0
#endif
#ifndef SKIPU
#define SKIPU 0
#endif
#ifndef SKIPM
#define SKIPM 0
#endif
#define GRID_BAR() do { XcdBarrier b2_ = bar; b2_.bar = (unsigned*)launder((GAS unsigned char*)bar.bar); b2_.x = (unsigned)launder_i((int)bar.x); xcd_barrier(b2_); } while (0)
#define PHASE_BEGIN() ws = launder(ws0); F.ws = ws; { int w_ = wave0; asm volatile("" : "+s"(w_)); int l_ = (int)__builtin_amdgcn_mbcnt_hi(~0u, __builtin_amdgcn_mbcnt_lo(~0u, 0u)); asm volatile("" : "+v"(l_)); F.wave = w_; F.lane = l_; F.tid = w_ * 64 + l_; } F.ctl = (gu32*)(ws + WS_CTL); const GAS unsigned char* wl = ws + WS_W + (size_t)l * W_LAYER; (void)wl; \
    GAS bf16* const xb_in = (GAS bf16*)(ws + ((l & 1) ? A_XB1 : A_XB0)); GAS bf16* const xb_out = (GAS bf16*)(ws + ((l & 1) ? A_XB0 : A_XB1)); (void)xb_in; (void)xb_out; GAS _Float16* const VA = (GAS _Float16*)(ws + A_VA); (void)VA;
DI void touch(const Frame& F, const GAS unsigned char* p, unsigned bytes) {
    const unsigned dump = (unsigned)__builtin_amdgcn_readfirstlane((int)((unsigned)(size_t)F.lds + 131072u));
    const unsigned np = bytes >> 10;
    for (unsigned i = (unsigned)(F.vcu * NWAVES + F.wave); i < np; i += (unsigned)(F.G * NWAVES)) at::glds16(p + ((size_t)i << 10) + F.lane * 16, dump);
}
#ifndef TOUCH
#define TOUCH 1
#endif
__global__ void __launch_bounds__(NWAVES * 64, 2) fwd(Args args) {
    extern __shared__ __attribute__((aligned(16))) unsigned char lds[];
    Frame F;
    F.lds = (LAS unsigned char*)lds;
    F.MISC = (volatile LAS unsigned*)(F.lds + MISC_OFF);
    F.tid = threadIdx.x; F.lane = F.tid & 63; F.wave = __builtin_amdgcn_readfirstlane(F.tid >> 6); const int wave0 = F.wave;
    F.G = gridDim.x; { const int bx = blockIdx.x; F.vcu = (F.G % 8 == 0) ? (bx % 8) * (F.G / 8) + bx / 8 : bx; }
    GAS unsigned char* const ws0 = (GAS unsigned char*)args.ws; GAS unsigned char* ws = ws0; F.ws = ws;
    F.ctl = (gu32*)(ws + WS_CTL);
    for (int u = F.tid; u < (LDS_BYTES - LDSCTL_OFF) / 4; u += NWAVES * 64) ((LAS unsigned*)(F.lds + LDSCTL_OFF))[u] = 0u;
    __syncthreads();
    XcdBarrier bar = xcd_barrier_post((unsigned*)(F.ctl + CW_BAR), F.MISC + 8);
    const int cid = (int)blockIdx.x;

    if (!(SKIPM & 1)) p0_prologue(F, args);
    GRID_BAR();
    if (DUPM & 1) { p0_prologue(F, args); GRID_BAR(); }
    if (TOUCH) touch(F, ws + WS_W + WO_IN, 4096u * 4096u + 7936u * 2048u);
    p0_cvec(F, args, 0);

    for (int l = 0; l < NL; ++l) {
        for (int rep_ = 0, nrep_ = launder_i(((DUPM >> 1) & 1) + 1); rep_ < nrep_; ++rep_) {
        if (!(SKIPM & (1 << 1))) {
            PHASE_BEGIN();
            {
                pg8::Gemm g{(const bf16*)(ws + A_X8B), (const bf16*)(wl + WO_ING8), MTOK, 7936, launder_i(1024), launder_i(0x7f7f7f7f), launder_i(0x7a7a7a7a)}; pg8::PanelOrder S; S.init(MTOK, 7936, F.G, cid);
                pg8::EpiInProj E{(GAS bf16*)(ws + A_FQ), (GAS bf16*)(ws + A_FK), (GAS bf16*)(ws + A_FV), (GAS bf16*)(ws + A_NQ), (GAS bf16*)(ws + A_KC), (GAS bf16*)(ws + A_VC), (GAS bf16*)(ws + A_KS), (GAS bf16*)(ws + A_VS),
                                 (GAS bf16*)(ws + A_KW), (GAS bf16*)(ws + A_VW), (GAS bf16*)(ws + A_DQ), (GAS bf16*)(ws + A_CKV), (GAS bf16*)(ws + A_IQ), (GAS bf16*)(ws + A_IK), ws + A_G, (GAS float*)(ws + A_SM),
                                 (const GAS pg8::f32x2e*)(ws + WS_ROPE128), (const GAS pg8::f32x2e*)(ws + WS_ROPE64), 1};
                pg8::gemm_phase<pg8::EpiInProj, pg8::PanelOrder, true, true, true>(F.lds + RING_OFF, g, S, E, wave0);
            }
            {
                pg8::Gemm g{(const bf16*)xb_in, (const bf16*)(wl + WO_IN), MTOK, 4096, launder_i(2048)}; pg8::PanelOrder S; S.init(MTOK, 4096, F.G, cid);
                pg8::EpiInProj E{(GAS bf16*)(ws + A_FQ), (GAS bf16*)(ws + A_FK), (GAS bf16*)(ws + A_FV), (GAS bf16*)(ws + A_NQ), (GAS bf16*)(ws + A_KC), (GAS bf16*)(ws + A_VC), (GAS bf16*)(ws + A_KS), (GAS bf16*)(ws + A_VS),
                                 (GAS bf16*)(ws + A_KW), (GAS bf16*)(ws + A_VW), (GAS bf16*)(ws + A_DQ), (GAS bf16*)(ws + A_CKV), (GAS bf16*)(ws + A_IQ), (GAS bf16*)(ws + A_IK), ws + A_G, (GAS float*)(ws + A_SM),
                                 (const GAS pg8::f32x2e*)(ws + WS_ROPE128), (const GAS pg8::f32x2e*)(ws + WS_ROPE64), 0};
                pg8::gemm_phase<pg8::EpiInProj, pg8::PanelOrder, true, true>(F.lds + RING_OFF, g, S, E, wave0);
            }

        }
        if (rep_ + 1 < nrep_) GRID_BAR();
        }
        GRID_BAR();
        for (int rep_ = 0, nrep_ = launder_i(((DUPM >> 4) & 1) + 1); rep_ < nrep_; ++rep_) {
        if (!(SKIPM & (1 << 4))) {
            PHASE_BEGIN();
            gu32* head = F.ctl + CW_Q + 64 * (l * 4 + 2 + 16 * rep_);
            gu32* flg = F.ctl + CW_FLAG + 320 * l;
            gu32* chead = F.ctl + CW_Q + 64 * (l * 4 + 1 + 16 * rep_); const bool conv = launder_i(l + 1) < NL;
            for (;;) {
                const int idx = q_next(F, head);
                { int l_ = F.lane; asm volatile("" : "+v"(l_)); F.lane = l_; F.tid = F.wave * 64 + l_; }
                if (idx >= 1056) { if (conv) while (conv_try(F, args, l + 1, chead)) {} break; }
                if (idx < 64) { compress1_unit(F, wl, l, idx); if ((UDUP >> 4) & 1) { __syncthreads(); compress1_unit(F, wl, l, idx); } unit_done(F, flg + 257); }
                else if (idx < 208) { const int i = idx - 64, b = i / 36; int r = i % 36, qb = 0; while (r > qb) { r -= qb + 1; ++qb; } indexer_unit(F, b, qb, r); if ((UDUP >> 0) & 1) { __syncthreads(); indexer_unit(F, b, qb, r); } unit_done(F, flg + 260 + 8 * b + qb); }
                else if (idx < 272) { kvup_unit(F, (const GAS bf16*)(wl + WO_KVUP), idx - 208); if ((UDUP >> 5) & 1) { __syncthreads(); kvup_unit(F, (const GAS bf16*)(wl + WO_KVUP), idx - 208); } unit_done(F, flg + 258); }
                else if (idx < 288) { unit_wait(F, flg + 257, flg + 257, 64u); compress2_unit(F, wl, idx - 272); unit_done(F, flg + 256); }
                else if (idx < 416) { const int nk = idx - 288;
                    if (conv) while (!unit_poll(F, flg + 256, 16u)) { if (!conv_try(F, args, l + 1, chead)) break; }
                    unit_wait(F, flg + 256, flg + 256, 16u); nsa_unit(F, nk & 3, 31 - (nk >> 2)); }
                else if (idx < 672) { const int i = idx - 416, b = i & 3, tb = 63 - (i >> 2), s = b * 64 + tb; if (conv) while (!unit_poll(F, flg + 260 + 8 * b + (tb >> 3), (unsigned)(tb >> 3) + 1u)) { if (!conv_try(F, args, l + 1, chead)) break; }
                    unit_wait(F, flg + 260 + 8 * b + (tb >> 3), flg + 260 + 8 * b + (tb >> 3), (unsigned)(tb >> 3) + 1u); dsa_select_unit(F, s); if ((UDUP >> 1) & 1) { __syncthreads(); dsa_select_unit(F, s); } unit_done(F, flg + s); }
                else if (idx < 768) { const int fk = idx - 672, qb = 7 - fk / 24, bh = fk % 24; fox_unit(F, (const GAS float*)args.in[3] + l * 6, bh / 6, bh % 6, qb);
                } else if (idx < 960) {
                    const int dk = idx - 768, b = dk & 3, u = 47 - (dk >> 2);
                    unit_wait(F, flg + 258, flg + 258, 64u);
                    unit_wait(F, flg + b * 64 + (8 * u) / 6, flg + b * 64 + (8 * u + 7) / 6, 1u);
                    dsa_attn_unit(F, b, u); if ((UDUP >> 2) & 1) { __syncthreads(); dsa_attn_unit(F, b, u); }
                } else { const int fk = idx - 960, qb = 3 - fk / 24, bh = fk % 24; fox_unit(F, (const GAS float*)args.in[3] + l * 6, bh / 6, bh % 6, qb); if ((UDUP >> 6) & 1) { __syncthreads(); fox_unit(F, (const GAS float*)args.in[3] + l * 6, bh / 6, bh % 6, qb); } }
            }
        }
        if (rep_ + 1 < nrep_) GRID_BAR();
        }
        GRID_BAR();
        for (int rep_ = 0, nrep_ = launder_i(((DUPM >> 5) & 1) + 1); rep_ < nrep_; ++rep_) {
        if (!(SKIPM & (1 << 5))) {
            PHASE_BEGIN();
            if (l + 1 < NL) p0_cvec(F, args, l + 1);
            if (TOUCH > 1) touch(F, wl + WO_OUT, 2048u * 2048u * 2u);
            pg8::SegOrder4 S; S.base.init(MTOK, DM, F.G, cid);
            pg8::SegGemm g{{(const bf16*)(ws + A_OF), (const bf16*)(ws + A_ON), (const bf16*)(ws + A_OD), (const bf16*)(ws + A_PB) + (size_t)l * MTOK * 768},
                           {(const bf16*)(wl + WO_BRF), (const bf16*)(wl + WO_BRN), (const bf16*)(wl + WO_BRD), (const bf16*)(wl + WO_PI)}, {12, 8, 12, 4}, launder_i(768)};
            pg8::EpiBranchSeg E{ws + A_G, (GAS bf16*)(ws + A_MIXB), (GAS bf16*)(ws + A_PLB)};
            pg8::gemm_phase<pg8::EpiBranchSeg, pg8::SegOrder4, true, true, false, pg8::SegGemm>(F.lds + RING_OFF, g, S, E, wave0);
        }
        if (rep_ + 1 < nrep_) GRID_BAR();
        }
        GRID_BAR();
        if (!(SKIPM & (1 << 6))) {
            PHASE_BEGIN();
            if (TOUCH > 1) touch(F, wl + WO_FFI, 11264u * 2048u);
            pg8::Gemm g{(const bf16*)(ws + A_MIXB), (const bf16*)(wl + WO_OUT), MTOK, DM, launder_i(2048)}; pg8::StaticOrder S; S.init(MTOK, DM, F.G, cid);
            pg8::EpiResidStats<false, true> E{VA, VA, ALPHA_F, nullptr, nullptr, nullptr, (const GAS float*)args.in[16] + (size_t)l * DM, ws + A_X8, (GAS pg8::f32x2e*)(ws + A_ST1), F.lds, F.tid};
            pg8::gemm_phase<pg8::EpiResidStats<false, true>, pg8::StaticOrder, true, true>(F.lds + RING_OFF, g, S, E, wave0);
        }
        GRID_BAR();
        for (int rep_ = 0, nrep_ = launder_i(((DUPM >> 8) & 1) + 1); rep_ < nrep_; ++rep_) {
        if (!(SKIPM & (1 << 8))) {
            PHASE_BEGIN();
            if (TOUCH > 1) touch(F, wl + WO_FFO, 2048u * 5632u);
            pg8::Gemm g{(const bf16*)(ws + A_X8), (const bf16*)(wl + WO_FFI), MTOK, 2 * DFF, launder_i(1024), launder_i(0x7f7f7f7f), launder_i(0x79797979)}; pg8::PanelOrder S; S.init(MTOK, 2 * DFF, F.G, cid);
            pg8::EpiSwiGLU E{ws + A_HID, (const GAS pg8::f32x2e*)(ws + A_ST1), (const GAS float*)(ws + A_CV) + (size_t)l * CV_LAYER, (const GAS float*)(ws + A_CV) + (size_t)l * CV_LAYER + 11264, F.lds, F.tid};
            pg8::gemm_phase<pg8::EpiSwiGLU, pg8::PanelOrder, true, true, true>(F.lds + RING_OFF, g, S, E, wave0);
        }
        if (rep_ + 1 < nrep_) GRID_BAR();
        }
        GRID_BAR();
        if (!(SKIPM & (1 << 9))) {
            PHASE_BEGIN();
            if (TOUCH > 1) touch(F, wl + WO_PG, 2048u * 2048u * 2u);
            pg8::Gemm g{(const bf16*)(ws + A_HID), (const bf16*)(wl + WO_FFO), MTOK, DM, launder_i(DFF / 2), launder_i(0x7b7b7b7b), launder_i(0x78787878)}; pg8::StaticOrder S; S.init(MTOK, DM, F.G, cid);
            pg8::EpiResidStats<true, false> E{VA, VA, ALPHA_F, (const GAS pg8::f32x2e*)(ws + A_ST1), (const GAS float*)args.in[16] + (size_t)l * DM, (const GAS float*)args.in[17] + (size_t)l * DM,
                                              (const GAS float*)args.in[20] + (size_t)l * DM, (GAS unsigned char*)xb_in, (GAS pg8::f32x2e*)(ws + A_ST2), F.lds, F.tid};
            pg8::gemm_phase<pg8::EpiResidStats<true, false>, pg8::StaticOrder, true, true, true>(F.lds + RING_OFF, g, S, E, wave0);
        }
        GRID_BAR();
        if (!(SKIPM & (1 << 11))) {
            PHASE_BEGIN();
            if (TOUCH && l + 1 < NL) { touch(F, wl + W_LAYER + WO_IN, 4096u * 4096u); touch(F, wl + W_LAYER + WO_ING8, 7936u * 2048u); }
            pg8::Gemm g{(const bf16*)xb_in, (const bf16*)(wl + WO_PG), MTOK, DM, launder_i(2048)}; pg8::StaticOrder S; S.init(MTOK, DM, F.G, cid);
            pg8::EpiPleGate E{VA, (const GAS bf16*)(ws + A_PLB), VA, l == NL - 1 ? (GAS float*)args.out : (GAS float*)nullptr, xb_out, ws + A_X8B, (const GAS pg8::f32x2e*)(ws + A_ST2), (const GAS float*)args.in[20] + (size_t)l * DM, (const GAS float*)args.in[21] + (size_t)l * DM,
                                 (const GAS float*)(ws + A_CV) + (size_t)l * CV_LAYER + 22528, (const GAS float*)(ws + A_CV) + (size_t)l * CV_LAYER + 22528 + 2048, F.lds, F.tid};
            pg8::gemm_phase<pg8::EpiPleGate, pg8::StaticOrder, true, true>(F.lds + RING_OFF, g, S, E, wave0);
        }
        if (l + 1 < NL) GRID_BAR();
    }
}

extern "C" void kernel_launch(void* const* d_in, const int* in_sizes, int n_in, void* d_out, int out_size, void* d_ws, size_t ws_size, hipStream_t stream) {
    static int grid = 0;
    if (grid == 0) {
        if (n_in != 24 || out_size != MTOK * DM || ws_size < WS_END) { fprintf(stderr, "kernel_launch: unexpected shapes (n_in %d, out %d, ws %zu < %zu)\n", n_in, out_size, ws_size, (size_t)WS_END); grid = -1; return; }
        int dev = 0, cus = 0, per_cu = 0;
        if (hipGetDevice(&dev) != hipSuccess || hipDeviceGetAttribute(&cus, hipDeviceAttributeMultiprocessorCount, dev) != hipSuccess) { grid = -1; return; }
        if (hipFuncSetAttribute((const void*)fwd, hipFuncAttributeMaxDynamicSharedMemorySize, LDS_BYTES) != hipSuccess) { fprintf(stderr, "kernel_launch: hipFuncSetAttribute failed\n"); grid = -1; return; }
        if (hipOccupancyMaxActiveBlocksPerMultiprocessor(&per_cu, (const void*)fwd, NWAVES * 64, LDS_BYTES) != hipSuccess || per_cu < 1) fprintf(stderr, "kernel_launch: occupancy query reports %d\n", per_cu);
        (void)hipGetLastError();
        grid = cus;
    }
    if (grid < 0) return;
    if (hipMemsetAsync((char*)d_ws + WS_CTL, 0, CTL_ZERO_BYTES, stream) != hipSuccess) return;
    Args a{};
    for (int i = 0; i < 24; ++i) a.in[i] = (const float*)d_in[i];
    a.out = (float*)d_out; a.ws = (unsigned char*)d_ws; a.pad0 = 0; a.pad1 = 0;
    hipLaunchKernelGGL(fwd, dim3(grid), dim3(NWAVES * 64), LDS_BYTES, stream, a);
}
```
